# Optimizing an MI355X kernel written in HIP

```python
import jax, jax.numpy as jnp
from jax import lax
import numpy as np

D_MODEL = 2048
BATCH = 8
SEQ = 2048
DEPTH = 4

N_MIXERS = 4
EPS = 1e-6
CHUNK = 64
RET_HEADS = 8
RET_DK = D_MODEL // RET_HEADS
RET_DV = 2 * RET_DK
RET_IN = 2 * RET_HEADS * RET_DK + 2 * RET_HEADS * RET_DV
ROPE_BASE = 10000.0
CONV_WIDTH = 3
GLA_HEADS = 4
GLA_DK = D_MODEL // 2 // GLA_HEADS
GLA_DV = D_MODEL // GLA_HEADS
GLA_GATE_RANK = 16
GLA_GATE_TAU = 16.0
GLA_IN = 2 * GLA_HEADS * GLA_DK + 2 * GLA_HEADS * GLA_DV + GLA_GATE_RANK
POOL_WINDOWS = (2, 4, 8, 16)
POOL_GROUPS = len(POOL_WINDOWS)
POOL_GROUP = D_MODEL // POOL_GROUPS
D_FF = -(-8 * D_MODEL // (3 * 256)) * 256
N_RET = (DEPTH + 3) // N_MIXERS
N_CONV = (DEPTH + 2) // N_MIXERS
N_GLA = (DEPTH + 1) // N_MIXERS
N_POOL = DEPTH // N_MIXERS

kernel_name = "interleaved_hybrid_ret_conv_gla_pool_adaln"


def rms_norm(x, gain=None):
    xf = x.astype(jnp.float32)
    y = xf * lax.rsqrt(jnp.mean(xf * xf, axis=-1, keepdims=True) + EPS)
    if gain is not None:
        y = y * gain.astype(jnp.float32)
    return y


def rope(t, cos, sin):
    t = t.astype(jnp.float32)
    half = t.shape[-1] // 2
    t1, t2 = t[..., :half], t[..., half:]
    return jnp.concatenate([t1 * cos - t2 * sin, t2 * cos + t1 * sin], axis=-1)


def chunked_gated_linear_attention(q, k, v, log_a):
    B, H, S, dk = q.shape
    dv = v.shape[-1]
    n = S // CHUNK

    def to_chunks(t):
        t = t.astype(jnp.float32)
        return t.reshape(t.shape[0], t.shape[1], n, CHUNK, t.shape[-1]).transpose(2, 0, 1, 3, 4)

    qc, kc, vc, gc = to_chunks(q), to_chunks(k), to_chunks(v), to_chunks(log_a)
    causal = jnp.tril(jnp.ones((CHUNK, CHUNK), dtype=bool))

    def step(state, inp):
        qi, ki, vi, gi = inp
        b = jnp.cumsum(gi, axis=-2)
        b_last = b[..., -1:, :]
        q_dec = qi * jnp.exp(b)
        k_dec = ki * jnp.exp(-b)
        scores = jnp.where(causal, jnp.einsum('bhid,bhjd->bhij', q_dec, k_dec), 0.0)
        o = jnp.einsum('bhij,bhjv->bhiv', scores, vi) + jnp.einsum('bhid,bhdv->bhiv', q_dec, state)
        k_carry = ki * jnp.exp(b_last - b)
        state = jnp.exp(b_last)[..., 0, :, None] * state + jnp.einsum('bhjd,bhjv->bhdv', k_carry, vi)
        return state, o

    state0 = jnp.zeros((B, H, dk, dv), jnp.float32)
    _, o = lax.scan(step, state0, (qc, kc, vc, gc))
    return o.transpose(1, 2, 0, 3, 4).reshape(B, H, S, dv)


def split_heads(t, n_heads):
    B, S, W = t.shape
    return t.reshape(B, S, n_heads, W // n_heads).transpose(0, 2, 1, 3)


def merge_heads(t):
    B, H, S, d = t.shape
    return t.transpose(0, 2, 1, 3).reshape(B, S, H * d)


def retention_mixer(h, cos, sin, w_in, w_out):
    B, S, _ = h.shape
    qk_w, v_w = RET_HEADS * RET_DK, RET_HEADS * RET_DV
    q, k, v, g = jnp.split(h @ w_in, [qk_w, 2 * qk_w, 2 * qk_w + v_w], axis=-1)
    q = rope(split_heads(q, RET_HEADS), cos, sin)
    k = rope(split_heads(k, RET_HEADS), cos, sin) * (RET_DK ** -0.5)
    v = split_heads(v, RET_HEADS)
    log_gamma = jnp.log1p(-jnp.exp2(-5.0 - jnp.arange(RET_HEADS, dtype=jnp.float32)))
    log_a = jnp.broadcast_to(log_gamma[None, :, None, None], (1, RET_HEADS, S, 1))
    o = rms_norm(chunked_gated_linear_attention(q, k, v, log_a))
    o = merge_heads(o).astype(h.dtype)
    return ((jax.nn.silu(g) * o) @ w_out).astype(h.dtype)


def short_conv_mixer(h, w_in, conv_w, w_out):
    S = h.shape[1]
    b_gate, c_gate, u = jnp.split(h @ w_in, 3, axis=-1)
    u = c_gate * u
    up = jnp.pad(u, ((0, 0), (CONV_WIDTH - 1, 0), (0, 0)))
    y = sum(conv_w[j] * up[:, j:j + S] for j in range(CONV_WIDTH))
    return ((b_gate * y) @ w_out).astype(h.dtype)


def gla_mixer(h, w_in, w_gate_up, b_gate, w_out):
    qk_w, v_w = GLA_HEADS * GLA_DK, GLA_HEADS * GLA_DV
    q, k, v, g, z = jnp.split(h @ w_in, [qk_w, 2 * qk_w, 2 * qk_w + v_w, 2 * qk_w + 2 * v_w], axis=-1)
    log_a = jax.nn.log_sigmoid((z @ w_gate_up + b_gate).astype(jnp.float32)) / GLA_GATE_TAU
    q = split_heads(q, GLA_HEADS).astype(jnp.float32) * (GLA_DK ** -0.5)
    o = chunked_gated_linear_attention(q, split_heads(k, GLA_HEADS), split_heads(v, GLA_HEADS),
                                       split_heads(log_a, GLA_HEADS))
    o = merge_heads(rms_norm(o)).astype(h.dtype)
    return ((jax.nn.silu(g) * o) @ w_out).astype(h.dtype)


def pool_mixer(h, w_group, scale):
    B, S, D = h.shape
    hf = h.astype(jnp.float32).reshape(B, S, POOL_GROUPS, POOL_GROUP)
    cs = jnp.concatenate([jnp.zeros((B, 1, POOL_GROUPS, POOL_GROUP), jnp.float32),
                          jnp.cumsum(hf, axis=1)], axis=1)
    t = jnp.arange(S)
    pooled = []
    for gi, win in enumerate(POOL_WINDOWS):
        start = jnp.maximum(t + 1 - win, 0)
        total = cs[:, 1:, gi] - cs[:, start, gi]
        count = (t + 1 - start).astype(jnp.float32)
        pooled.append(total / count[None, :, None])
    mixed = jnp.stack(pooled, axis=2) - hf
    y = jnp.einsum('bsgp,gpq->bsgq', mixed, w_group.astype(jnp.float32)).reshape(B, S, D)
    return (y * scale).astype(h.dtype)


def swiglu(h, w_in, w_out):
    a, b = jnp.split(h @ w_in, 2, axis=-1)
    return (jax.nn.silu(a) * b) @ w_out


def _normal(key, shape, scale):
    return jax.random.normal(key, shape, jnp.float32) * scale


def setup_inputs(seed: int = 0) -> dict:
    key = jax.random.key(seed)
    ks = jax.random.split(key, 20)
    D = D_MODEL
    return {
        "x": _normal(ks[0], (BATCH, SEQ, D), 1.0),
        "c": _normal(ks[1], (BATCH, D), 1.0),
        "positions": jnp.broadcast_to(jnp.arange(SEQ, dtype=jnp.int32), (BATCH, SEQ)),
        "w_mod": _normal(ks[2], (DEPTH, D, 6 * D), 0.5 * D ** -0.5),
        "b_mod": _normal(ks[3], (DEPTH, 6 * D), 0.02),
        "norm1_g": 1.0 + _normal(ks[4], (DEPTH, D), 0.02),
        "norm2_g": 1.0 + _normal(ks[5], (DEPTH, D), 0.02),
        "ret_w_in": _normal(ks[6], (N_RET, D, RET_IN), D ** -0.5),
        "ret_w_out": _normal(ks[7], (N_RET, RET_HEADS * RET_DV, D), (RET_HEADS * RET_DV) ** -0.5),
        "conv_w_in": _normal(ks[8], (N_CONV, D, 3 * D), D ** -0.5),
        "conv_w": _normal(ks[9], (N_CONV, CONV_WIDTH, D), CONV_WIDTH ** -0.5),
        "conv_w_out": _normal(ks[10], (N_CONV, D, D), D ** -0.5),
        "gla_w_in": _normal(ks[11], (N_GLA, D, GLA_IN), D ** -0.5),
        "gla_w_gate_up": _normal(ks[12], (N_GLA, GLA_GATE_RANK, GLA_HEADS * GLA_DK), GLA_GATE_RANK ** -0.5),
        "gla_b_gate": _normal(ks[13], (N_GLA, GLA_HEADS * GLA_DK), 0.02),
        "gla_w_out": _normal(ks[14], (N_GLA, GLA_HEADS * GLA_DV, D), (GLA_HEADS * GLA_DV) ** -0.5),
        "pool_w": _normal(ks[15], (N_POOL, POOL_GROUPS, POOL_GROUP, POOL_GROUP), POOL_GROUP ** -0.5),
        "pool_scale": 1.0 + _normal(ks[16], (N_POOL, D), 0.1),
        "ffn_w_in": _normal(ks[17], (DEPTH, D, 2 * D_FF), D ** -0.5),
        "ffn_w_out": _normal(ks[18], (DEPTH, D_FF, D), D_FF ** -0.5),
        "final_g": 1.0 + _normal(ks[19], (D,), 0.02),
    }


def reference(x, c, positions, w_mod, b_mod, norm1_g, norm2_g, ret_w_in, ret_w_out,
              conv_w_in, conv_w, conv_w_out, gla_w_in, gla_w_gate_up, gla_b_gate, gla_w_out,
              pool_w, pool_scale, ffn_w_in, ffn_w_out, final_g):
    half = RET_DK // 2
    inv_freq = jnp.power(ROPE_BASE, -jnp.linspace(0.0, 1.0, half, dtype=jnp.float32))
    ang = positions.astype(jnp.float32)[:, None, :, None] * inv_freq
    cos, sin = jnp.cos(ang), jnp.sin(ang)
    c_act = jax.nn.silu(c)
    for i in range(DEPTH):
        mod = (c_act @ w_mod[i] + b_mod[i])[:, None, :]
        sh1, sc1, g1, sh2, sc2, g2 = jnp.split(mod, 6, axis=-1)
        h = (rms_norm(x, norm1_g[i]) * (1.0 + sc1) + sh1).astype(x.dtype)
        m, j = i % N_MIXERS, i // N_MIXERS
        if m == 0:
            y = retention_mixer(h, cos, sin, ret_w_in[j], ret_w_out[j])
        elif m == 1:
            y = short_conv_mixer(h, conv_w_in[j], conv_w[j], conv_w_out[j])
        elif m == 2:
            y = gla_mixer(h, gla_w_in[j], gla_w_gate_up[j], gla_b_gate[j], gla_w_out[j])
        else:
            y = pool_mixer(h, pool_w[j], pool_scale[j])
        x = (x + g1 * y).astype(x.dtype)
        h = (rms_norm(x, norm2_g[i]) * (1.0 + sc2) + sh2).astype(x.dtype)
        x = (x + g2 * swiglu(h, ffn_w_in[i], ffn_w_out[i])).astype(x.dtype)
    return rms_norm(x, final_g).astype(x.dtype)
```

```cpp
#include <hip/hip_runtime.h>
#include <cstdio>
#include <cstdint>

#ifndef FP8_FFN_MASK
#define FP8_FFN_MASK 0x0
#endif
#ifndef MK_ONE_LAUNCH
#define MK_ONE_LAUNCH 1
#endif

namespace pg8 {
#define PG8_LAS __attribute__((address_space(3)))
typedef unsigned short bf16_t;
typedef short bf16x8 __attribute__((ext_vector_type(8)));
typedef float f32x4 __attribute__((ext_vector_type(4)));
typedef unsigned u32x4 __attribute__((ext_vector_type(4)));
constexpr int BM = 256, BK = 64, HALF = 128, HTB = HALF * BK * 2, STAGE_BYTES = 8 * HTB, NXCD = 8, WGM = 8;

__host__ __device__ __forceinline__ int lds_byte(int r, int c) { const int st = (r >> 4) * 2 + (c >> 5), rr = r & 15, cc = c & 31, ob = rr * 64 + cc * 2; return st * 1024 + (ob ^ (((ob >> 9) & 1) << 5)); }
__host__ __device__ __forceinline__ void stage_rc(int b, int& R, int& C) { const int st = b / 1024, sb = b % 1024, swz = sb ^ (((sb >> 9) & 1) << 5); R = (st >> 1) * 16 + swz / 64; C = (st & 1) * 32 + (swz % 64) / 2; }
__host__ __device__ __forceinline__ int perm32(int rho) { const int n = rho >> 4, i = rho & 15; return 8 * (i >> 2) + 4 * n + (i & 3); }

struct Unit { int pm, pn; };
struct Gemm { const bf16_t* A; const bf16_t* Bt; int M, N, K, lda, ldb, grp; };

struct StaticOrder {
    int nM, nN, nwg, G, c;
    __host__ __device__ void init(int M, int N, int G_, int c_) { nM = M / BM; nN = N / BM; nwg = nM * nN; G = G_; c = c_; }
    __host__ __device__ bool next(int i, Unit& u) const {
        const long L = (long)i * G + c; if (L >= nwg) return false;
        int wgid = (int)L; { const int q = nwg / NXCD, r = nwg % NXCD, xcd = wgid % NXCD, off = wgid / NXCD; wgid = (xcd < r ? xcd * (q + 1) : r * (q + 1) + (xcd - r) * q) + off; }
        const int nig = WGM * nN, gid = wgid / nig, fm = gid * WGM, gsz = (nM - fm) < WGM ? (nM - fm) : WGM;
        u.pm = fm + ((wgid % nig) % gsz); u.pn = (wgid % nig) / gsz; return true;
    }
    __device__ __forceinline__ void a_ready(const Unit&) const {}
    __device__ __forceinline__ void done(const Unit&) const {}
};

__device__ __forceinline__ unsigned cvt_pk_bf16(float lo, float hi) { unsigned r; asm volatile("v_cvt_pk_bf16_f32 %0, %1, %2" : "=v"(r) : "v"(lo), "v"(hi)); return r; }
typedef int v8i_t __attribute__((ext_vector_type(8)));
typedef int v4i_t __attribute__((ext_vector_type(4)));
__device__ __forceinline__ float silu_f(float x) { return x * __builtin_amdgcn_rcpf(1.0f + __expf(-x)); }
__device__ __forceinline__ u32x4 pack8(const f32x4& a, const f32x4& b) { u32x4 w; w.x = cvt_pk_bf16(a[0], a[1]); w.y = cvt_pk_bf16(a[2], a[3]); w.z = cvt_pk_bf16(b[0], b[1]); w.w = cvt_pk_bf16(b[2], b[3]); return w; }


template <bool SCALED>
struct EpiSwigluT {
    static constexpr bool PERM = true, AFTER_DRAIN = false; static constexpr int NST = 8;
    bf16_t* O; int ldc; float sc;
    __device__ __forceinline__ void operator()(const f32x4 (&acc)[2][2][4][2], const Unit& u, int wr, int wc, int fr, int fq) const {
        const int row0 = u.pm * BM + wr * 64 + fr, col0 = u.pn * HALF + wc * 32 + 8 * fq;
#pragma unroll
        for (int ai = 0; ai < 2; ++ai)
#pragma unroll
            for (int m = 0; m < 4; ++m) { bf16_t* rowp = O + (size_t)(row0 + ai * HALF + m * 16) * ldc + col0;
                f32x4 v0, v1;
#pragma unroll
                for (int e = 0; e < 4; ++e) { if constexpr (SCALED) { v0[e] = silu_f(acc[ai][0][m][0][e] * sc) * (acc[ai][1][m][0][e] * sc); v1[e] = silu_f(acc[ai][0][m][1][e] * sc) * (acc[ai][1][m][1][e] * sc); }
                    else { v0[e] = silu_f(acc[ai][0][m][0][e]) * acc[ai][1][m][0][e]; v1[e] = silu_f(acc[ai][0][m][1][e]) * acc[ai][1][m][1][e]; } }
                *(u32x4*)rowp = pack8(v0, v1); }
    }
};
typedef EpiSwigluT<false> EpiSwiglu;
typedef EpiSwigluT<true> EpiSwigluS;
struct EpiRetIn {
    static constexpr bool PERM = true, AFTER_DRAIN = false; static constexpr int NST = 16;
    bf16_t *Q, *Kb, *V, *G; const float *cosT, *sinT;
    __device__ __forceinline__ void operator()(const f32x4 (&acc)[2][2][4][2], const Unit& u, int wr, int wc, int fr, int fq) const {
        const int row0 = u.pm * BM + wr * 64 + fr, cl = wc * 32 + 8 * fq;
        if (u.pn < 16) {
            const bool isk = u.pn >= 8; const int head = u.pn & 7; bf16_t* base = isk ? Kb : Q;
            const float l2g = log1pf(-exp2f(-5.0f - (float)head)) * 1.4426950408889634f;
#pragma unroll
            for (int ai = 0; ai < 2; ++ai)
#pragma unroll
                for (int m = 0; m < 4; ++m) { const int row = row0 + ai * HALF + m * 16;
                    const float tcp = (float)((row & 63) + 1);
                    const float sc = isk ? 0.0625f * exp2f(-tcp * l2g) : exp2f(tcp * l2g);
                    const f32x4 c0 = *(const f32x4*)(cosT + (size_t)row * 128 + cl), c1 = *(const f32x4*)(cosT + (size_t)row * 128 + cl + 4);
                    const f32x4 s0 = *(const f32x4*)(sinT + (size_t)row * 128 + cl), s1 = *(const f32x4*)(sinT + (size_t)row * 128 + cl + 4);
                    const f32x4 a0 = acc[ai][0][m][0], a1 = acc[ai][0][m][1], b0 = acc[ai][1][m][0], b1 = acc[ai][1][m][1];
                    const f32x4 o10 = (a0 * c0 - b0 * s0) * sc, o11 = (a1 * c1 - b1 * s1) * sc, o20 = (b0 * c0 + a0 * s0) * sc, o21 = (b1 * c1 + a1 * s1) * sc;
                    bf16_t* rowp = base + (size_t)row * 2048 + head * 256 + cl;
                    *(u32x4*)rowp = pack8(o10, o11); *(u32x4*)(rowp + HALF) = pack8(o20, o21); }
        } else {
            const bool isg = u.pn >= 32; bf16_t* base = (isg ? G : V) + ((u.pn - (isg ? 32 : 16)) * 256 + cl);
#pragma unroll
            for (int ai = 0; ai < 2; ++ai)
#pragma unroll
                for (int m = 0; m < 4; ++m) { bf16_t* rowp = base + (size_t)(row0 + ai * HALF + m * 16) * 4096;
#pragma unroll
                    for (int bj = 0; bj < 2; ++bj) { f32x4 v0 = acc[ai][bj][m][0], v1 = acc[ai][bj][m][1];
                        if (isg) {
#pragma unroll
                            for (int e = 0; e < 4; ++e) { v0[e] = silu_f(v0[e]); v1[e] = silu_f(v1[e]); } }
                        *(u32x4*)(rowp + bj * HALF) = pack8(v0, v1); } }
        }
    }
};
struct EpiConvIn {
    static constexpr bool PERM = true, AFTER_DRAIN = false; static constexpr int NST = 8;
    bf16_t *Bg, *CU;
    __device__ __forceinline__ void operator()(const f32x4 (&acc)[2][2][4][2], const Unit& u, int wr, int wc, int fr, int fq) const {
        const int row0 = u.pm * BM + wr * 64 + fr, cl = wc * 32 + 8 * fq;
        if (u.pn < 8) {
#pragma unroll
            for (int ai = 0; ai < 2; ++ai)
#pragma unroll
                for (int m = 0; m < 4; ++m) { bf16_t* rowp = Bg + (size_t)(row0 + ai * HALF + m * 16) * 2048 + u.pn * 256 + cl;
#pragma unroll
                    for (int bj = 0; bj < 2; ++bj) *(u32x4*)(rowp + bj * HALF) = pack8(acc[ai][bj][m][0], acc[ai][bj][m][1]); }
        } else {
#pragma unroll
            for (int ai = 0; ai < 2; ++ai)
#pragma unroll
                for (int m = 0; m < 4; ++m) { bf16_t* rowp = CU + (size_t)(row0 + ai * HALF + m * 16) * 2048 + (u.pn - 8) * HALF + cl;
                    *(u32x4*)rowp = pack8(acc[ai][0][m][0] * acc[ai][1][m][0], acc[ai][0][m][1] * acc[ai][1][m][1]); }
        }
    }
};
struct EpiGlaIn {
    static constexpr bool PERM = true, AFTER_DRAIN = false; static constexpr int NST = 16;
    bf16_t *Q, *Kb, *V, *G;
    __device__ __forceinline__ void operator()(const f32x4 (&acc)[2][2][4][2], const Unit& u, int wr, int wc, int fr, int fq) const {
        const int row0 = u.pm * BM + wr * 64 + fr, cl = wc * 32 + 8 * fq;
        bf16_t* base; int ld; float sc = 1.f; const bool isg = u.pn >= 16;
        if (u.pn < 4) { base = Q + u.pn * 256; ld = 1024; sc = 0.0625f; } else if (u.pn < 8) { base = Kb + (u.pn - 4) * 256; ld = 1024; }
        else if (u.pn < 16) { base = V + (u.pn - 8) * 256; ld = 2048; } else { base = G + (u.pn - 16) * 256; ld = 2048; }
#pragma unroll
        for (int ai = 0; ai < 2; ++ai)
#pragma unroll
            for (int m = 0; m < 4; ++m) { bf16_t* rowp = base + (size_t)(row0 + ai * HALF + m * 16) * ld + cl;
#pragma unroll
                for (int bj = 0; bj < 2; ++bj) { f32x4 v0 = acc[ai][bj][m][0] * sc, v1 = acc[ai][bj][m][1] * sc;
                    if (isg) {
#pragma unroll
                        for (int e = 0; e < 4; ++e) { v0[e] = silu_f(v0[e]); v1[e] = silu_f(v1[e]); } }
                    *(u32x4*)(rowp + bj * HALF) = pack8(v0, v1); } }
    }
};
struct EpiNull {
    static constexpr bool PERM = true, AFTER_DRAIN = false; static constexpr int NST = 0;
    bf16_t* O;
    __device__ __forceinline__ void operator()(const f32x4 (&acc)[2][2][4][2], const Unit& u, int wr, int wc, int fr, int fq) const {
        float s = 0.f;
#pragma unroll
        for (int ai = 0; ai < 2; ++ai)
#pragma unroll
            for (int bj = 0; bj < 2; ++bj)
#pragma unroll
                for (int m = 0; m < 4; ++m)
#pragma unroll
                    for (int n = 0; n < 2; ++n) s += acc[ai][bj][m][n][0] + acc[ai][bj][m][n][1] + acc[ai][bj][m][n][2] + acc[ai][bj][m][n][3];
        if (s == 1.2345e30f) O[u.pm + fr] = 0;
    }
};
template <bool XIN_F32>
struct EpiRes {
    static constexpr bool PERM = true, AFTER_DRAIN = false; static constexpr int NST = 16;
    const void* xin; bf16_t* xout; const float* gate; const float* cscale;
    __device__ __forceinline__ void operator()(const f32x4 (&acc)[2][2][4][2], const Unit& u, int wr, int wc, int fr, int fq) const {
        const int row0 = u.pm * BM + wr * 64 + fr, col0 = u.pn * BM + wc * 32 + 8 * fq;
        const float* gp = gate + (size_t)(u.pm >> 3) * 12288 + col0;
        f32x4 gv[2][2];
#pragma unroll
        for (int bj = 0; bj < 2; ++bj)
#pragma unroll
            for (int n = 0; n < 2; ++n) { gv[bj][n] = *(const f32x4*)(gp + bj * HALF + n * 4); if (cscale) gv[bj][n] = gv[bj][n] * *(const f32x4*)(cscale + col0 + bj * HALF + n * 4); }
        if constexpr (XIN_F32) {
#pragma unroll
            for (int ai = 0; ai < 2; ++ai)
#pragma unroll
                for (int mh = 0; mh < 2; ++mh) { f32x4 xv[2][2][2];
#pragma unroll
                    for (int m2 = 0; m2 < 2; ++m2)
#pragma unroll
                        for (int bj = 0; bj < 2; ++bj) { const float* p = (const float*)xin + (size_t)(row0 + ai * HALF + (2 * mh + m2) * 16) * 2048 + col0 + bj * HALF; xv[m2][bj][0] = *(const f32x4*)p; xv[m2][bj][1] = *(const f32x4*)(p + 4); }
#pragma unroll
                    for (int m2 = 0; m2 < 2; ++m2)
#pragma unroll
                        for (int bj = 0; bj < 2; ++bj) { const int m = 2 * mh + m2;
                            *(u32x4*)(xout + (size_t)(row0 + ai * HALF + m * 16) * 2048 + col0 + bj * HALF) = pack8(xv[m2][bj][0] + gv[bj][0] * acc[ai][bj][m][0], xv[m2][bj][1] + gv[bj][1] * acc[ai][bj][m][1]); }
                    asm volatile("" ::: "memory"); }
        } else {
#pragma unroll
            for (int ai = 0; ai < 2; ++ai) { u32x4 xw[4][2];
#pragma unroll
                for (int m = 0; m < 4; ++m)
#pragma unroll
                    for (int bj = 0; bj < 2; ++bj) xw[m][bj] = *(const u32x4*)((const bf16_t*)xin + (size_t)(row0 + ai * HALF + m * 16) * 2048 + col0 + bj * HALF);
#pragma unroll
                for (int m = 0; m < 4; ++m)
#pragma unroll
                    for (int bj = 0; bj < 2; ++bj) { const u32x4 w = xw[m][bj];
                        const f32x4 x0 = (f32x4){__builtin_bit_cast(float, w.x << 16), __builtin_bit_cast(float, w.x & 0xffff0000u), __builtin_bit_cast(float, w.y << 16), __builtin_bit_cast(float, w.y & 0xffff0000u)};
                        const f32x4 x1 = (f32x4){__builtin_bit_cast(float, w.z << 16), __builtin_bit_cast(float, w.z & 0xffff0000u), __builtin_bit_cast(float, w.w << 16), __builtin_bit_cast(float, w.w & 0xffff0000u)};
                        *(u32x4*)(xout + (size_t)(row0 + ai * HALF + m * 16) * 2048 + col0 + bj * HALF) = pack8(x0 + gv[bj][0] * acc[ai][bj][m][0], x1 + gv[bj][1] * acc[ai][bj][m][1]); }
                asm volatile("" ::: "memory"); }
        }
    }
};

template <class Epi, class Sched, bool ALIGN_EPI = true, bool SP2 = true, bool FULLLINE = false, bool NOSTAGE = false, bool FP8 = false>
__device__ __forceinline__ void gemm_phase(PG8_LAS unsigned char* lds, const Gemm g, const Sched& S, const Epi& E) {
    const int tid = threadIdx.x, wid = __builtin_amdgcn_readfirstlane(tid >> 6), lane = tid & 63, wr = wid >> 2, wc = wid & 3, fr = lane & 15, fq = lane >> 4;
    const int K = g.K, nt = K / BK;
    unsigned voffA_, voffB_;
    { int R, C; stage_rc(tid * 16, R, C); const int Rb = Epi::PERM ? ((R & ~31) + perm32(R & 31)) : R;
      voffA_ = (unsigned)(R * g.lda + C) * 2u; voffB_ = (unsigned)(Rb * g.ldb + C) * 2u; }
    const unsigned voffA = voffA_, voffB = voffB_;
    const size_t pstepoffA = (size_t)64 * g.lda * 2, pstepoffB = (size_t)64 * g.ldb * 2;
    const size_t kstep = (size_t)(BK * 2);
    const size_t hstepA = (size_t)HALF * g.lda * 2, hstepB = (size_t)HALF * g.ldb * 2;
    const size_t tstepA = 2 * hstepA, tstepB = 2 * hstepB;
    const unsigned ldsw = (unsigned)wid * 1024u;
    const int aoff = lds_byte(wr * 64 + fr, fq * 8), boff = lds_byte(wc * 32 + fr, fq * 8);
#define PG8_SA(b, h) (((b) * 2 + (h)) * HTB)
#define PG8_SB(b, h) ((4 + (b) * 2 + (h)) * HTB)
#define PG8_STAGE(bufoff, gbase, voff) do { if constexpr (!NOSTAGE) _Pragma("unroll") for (int _i = 0; _i < 2; ++_i) \
        __builtin_amdgcn_global_load_lds((const unsigned*)((const char*)(gbase) + (size_t)_i * pstep##voff + v##voff), (PG8_LAS unsigned*)(lds + (bufoff) + ldsw + _i * 8192), 16, 0, 0); } while (0)
#define PG8_LDA(dst, b, h) do { _Pragma("unroll") for (int m = 0; m < 4; ++m) { const v4i_t l0_ = *(const PG8_LAS v4i_t*)(lds + PG8_SA(b, h) + aoff + m * 2048), l1_ = *(const PG8_LAS v4i_t*)(lds + PG8_SA(b, h) + aoff + m * 2048 + 1024); \
        dst[m] = __builtin_shufflevector(l0_, l1_, 0, 1, 2, 3, 4, 5, 6, 7); } } while (0)
#define PG8_LDB(dst, b, h) do { _Pragma("unroll") for (int n = 0; n < 2; ++n) { const v4i_t l0_ = *(const PG8_LAS v4i_t*)(lds + PG8_SB(b, h) + boff + n * 2048), l1_ = *(const PG8_LAS v4i_t*)(lds + PG8_SB(b, h) + boff + n * 2048 + 1024); \
        dst[n] = __builtin_shufflevector(l0_, l1_, 0, 1, 2, 3, 4, 5, 6, 7); } } while (0)
#define PG8_MMA(ai, bj, At, Bt) do { __builtin_amdgcn_s_setprio(1); _Pragma("unroll") for (int m = 0; m < 4; ++m) _Pragma("unroll") for (int n = 0; n < 2; ++n) { \
        if constexpr (FP8) acc[ai][bj][m][n] = __builtin_amdgcn_mfma_scale_f32_16x16x128_f8f6f4(Bt[n], At[m], acc[ai][bj][m][n], 0, 0, 0, 0x7f7f7f7f, 0, 0x7f7f7f7f); \
        else { const v4i_t a0_ = __builtin_shufflevector(At[m], At[m], 0, 1, 2, 3), a1_ = __builtin_shufflevector(At[m], At[m], 4, 5, 6, 7), b0_ = __builtin_shufflevector(Bt[n], Bt[n], 0, 1, 2, 3), b1_ = __builtin_shufflevector(Bt[n], Bt[n], 4, 5, 6, 7); \
            acc[ai][bj][m][n] = __builtin_amdgcn_mfma_f32_16x16x32_bf16(__builtin_bit_cast(bf16x8, b0_), __builtin_bit_cast(bf16x8, a0_), acc[ai][bj][m][n], 0, 0, 0); \
            acc[ai][bj][m][n] = __builtin_amdgcn_mfma_f32_16x16x32_bf16(__builtin_bit_cast(bf16x8, b1_), __builtin_bit_cast(bf16x8, a1_), acc[ai][bj][m][n], 0, 0, 0); } } __builtin_amdgcn_s_setprio(0); } while (0)
#define PG8_WAIT_V(n) asm volatile("s_waitcnt vmcnt(" #n ")" ::: "memory")
#define PG8_WAIT_L(n) asm volatile("s_waitcnt lgkmcnt(" #n ")" ::: "memory")
#define PG8_BAR __builtin_amdgcn_s_barrier()
#define PG8_SCHED __builtin_amdgcn_sched_barrier(0)
#define PG8_ABASE(u) ((const char*)g.A + (size_t)(u).pm * tstepA + (g.grp ? (size_t)(((u).pn * BM) / g.grp) * (size_t)g.grp * 2 : (size_t)0))
#define PG8_BBASE(u) ((const char*)g.Bt + (size_t)(u).pn * tstepB)
    Unit cur, nxt; int ui = 0;
    if (!S.next(0, cur)) return;
    f32x4 acc[2][2][4][2];
#pragma unroll
    for (int a = 0; a < 2; ++a)
#pragma unroll
        for (int b = 0; b < 2; ++b)
#pragma unroll
            for (int m = 0; m < 4; ++m)
#pragma unroll
                for (int n = 0; n < 2; ++n) acc[a][b][m][n] = (f32x4){0.f, 0.f, 0.f, 0.f};
    v8i_t At[4], B0[2], B1[2];
    const char* cA = PG8_ABASE(cur); const char* cB = PG8_BBASE(cur);
    S.a_ready(cur);
    if constexpr (SP2) {
    PG8_STAGE(PG8_SB(0, 0), cB, offB); PG8_STAGE(PG8_SB(0, 1), cB + hstepB, offB); PG8_STAGE(PG8_SA(0, 0), cA, offA); PG8_STAGE(PG8_SA(0, 1), cA + hstepA, offA);
    if (wr == 1) PG8_BAR;
    PG8_WAIT_V(2); PG8_BAR;
    PG8_STAGE(PG8_SB(1, 0), cB + kstep, offB); PG8_STAGE(PG8_SA(1, 0), cA + kstep, offA); PG8_STAGE(PG8_SB(1, 1), cB + hstepB + kstep, offB);
    PG8_WAIT_V(0); PG8_BAR;
    } else {
    PG8_STAGE(PG8_SB(0, 0), cB, offB); PG8_STAGE(PG8_SA(0, 0), cA, offA); PG8_STAGE(PG8_SB(0, 1), cB + hstepB, offB); PG8_STAGE(PG8_SA(0, 1), cA + hstepA, offA);
    if (wr == 1) PG8_BAR;
    PG8_WAIT_V(4); PG8_BAR;
    PG8_STAGE(PG8_SB(1, 0), cB + kstep, offB); PG8_STAGE(PG8_SA(1, 0), cA + kstep, offA); PG8_STAGE(PG8_SB(1, 1), cB + hstepB + kstep, offB);
    PG8_WAIT_V(6); PG8_BAR;
    }
    for (;;) {
        const bool has_next = S.next(ui + 1, nxt);
        const char* nA = has_next ? PG8_ABASE(nxt) : cA; const char* nB = has_next ? PG8_BBASE(nxt) : cB;
#define PG8_ITER(WAITA) do { \
            const bool last = (t == nt - 2); \
            const char* a1 = cA + (size_t)(t + 1) * kstep; \
            const char* a2 = last ? nA : cA + (size_t)(t + 2) * kstep; const char* b2 = last ? nB : cB + (size_t)(t + 2) * kstep; \
            const char* a3 = a2 + kstep; const char* b3 = b2 + kstep; \
            if (last && has_next) S.a_ready(nxt); \
            PG8_LDB(B0, 0, 0); PG8_LDB(B1, 0, 1); PG8_SCHED; PG8_LDA(At, 0, 0); PG8_STAGE(PG8_SA(1, 1), a1 + hstepA, offA); \
            WAITA; PG8_WAIT_L(0); PG8_BAR; PG8_MMA(0, 0, At, B0); PG8_MMA(0, 1, At, B1); PG8_BAR; PG8_SCHED; \
            PG8_LDA(At, 0, 1); PG8_STAGE(PG8_SB(0, 0), b2, offB); PG8_STAGE(PG8_SB(0, 1), b2 + hstepB, offB); PG8_STAGE(PG8_SA(0, 0), a2, offA); \
            WAITA; PG8_WAIT_L(0); PG8_BAR; PG8_MMA(1, 0, At, B0); PG8_MMA(1, 1, At, B1); PG8_BAR; PG8_SCHED; \
            PG8_LDB(B0, 1, 0); PG8_LDB(B1, 1, 1); PG8_SCHED; PG8_LDA(At, 1, 0); PG8_STAGE(PG8_SA(0, 1), a2 + hstepA, offA); \
            PG8_WAIT_V(8); PG8_WAIT_L(0); PG8_BAR; PG8_MMA(0, 0, At, B0); PG8_MMA(0, 1, At, B1); PG8_BAR; PG8_SCHED; \
            PG8_LDA(At, 1, 1); PG8_STAGE(PG8_SB(1, 0), b3, offB); PG8_STAGE(PG8_SB(1, 1), b3 + hstepB, offB); PG8_STAGE(PG8_SA(1, 0), a3, offA); \
            PG8_WAIT_V(8); PG8_WAIT_L(0); PG8_BAR; PG8_MMA(1, 0, At, B0); PG8_MMA(1, 1, At, B1); PG8_BAR; PG8_SCHED; } while (0)
        static_assert(SP2, "only the SP2 loop is kept");
        { const int t = 0; if constexpr (Epi::NST == 16) PG8_ITER(PG8_WAIT_V(24)); else if constexpr (Epi::NST == 8) PG8_ITER(PG8_WAIT_V(16)); else PG8_ITER(PG8_WAIT_V(8)); }
        for (int t = 2; t < nt; t += 2) PG8_ITER(PG8_WAIT_V(8));
#undef PG8_ITER
        if constexpr (ALIGN_EPI) { if (wr == 0) PG8_BAR; }
        { int ln_ = lane; asm volatile("" : "+v"(ln_));
          E(acc, cur, wr, wc, ln_ & 15, ln_ >> 4); } S.done(cur);
        if (!has_next) break;
#pragma unroll
        for (int a = 0; a < 2; ++a)
#pragma unroll
            for (int b = 0; b < 2; ++b)
#pragma unroll
                for (int m = 0; m < 4; ++m)
#pragma unroll
                    for (int n = 0; n < 2; ++n) acc[a][b][m][n] = (f32x4){0.f, 0.f, 0.f, 0.f};
        cur = nxt; cA = nA; cB = nB; ++ui;
        if constexpr (ALIGN_EPI) { if (wr == 1) PG8_BAR; }
    }
    PG8_WAIT_V(0);
    if constexpr (!ALIGN_EPI) { if (wr == 0) PG8_BAR; }
    PG8_BAR;
#undef PG8_SA
#undef PG8_SB
#undef PG8_STAGE
#undef PG8_LDA
#undef PG8_LDB
#undef PG8_MMA
#undef PG8_WAIT_V
#undef PG8_WAIT_L
#undef PG8_BAR
#undef PG8_SCHED
#undef PG8_ABASE
#undef PG8_BBASE
}
}

constexpr int NWAVES = 8;
constexpr int BATCH = 8, SEQ = 2048, D = 2048, M = BATCH * SEQ, DEPTH = 4;
constexpr int FF = 5632, FF2 = 2 * FF;
constexpr int RET_H = 8, RET_IN = 12288, RET_VW = 4096;
constexpr int GLA_H = 4, GLA_QK = 1024, GLA_VW = 2048, GLA_INW = 6160, GLA_MAIN = 6144;
constexpr int CONV_INW = 6144;
constexpr float EPS = 1e-6f;
constexpr int MODW = 6 * D;

constexpr size_t MiB = 1u << 20;
constexpr size_t WS_CTL = 0, CTL_ZERO_BYTES = 1 * MiB;
constexpr size_t WS_MOD = 1 * MiB;
constexpr size_t WS_Z = 3 * MiB;
constexpr size_t WS_WZT = 4 * MiB;
constexpr size_t WS_COS = 5 * MiB, WS_SIN = 13 * MiB;
constexpr size_t WS_W_RET_IN = 21 * MiB;
constexpr size_t WS_W_RET_OUT = 69 * MiB;
constexpr size_t WS_W_CONV_IN = 85 * MiB;
constexpr size_t WS_W_CONV_OUT = 109 * MiB;
constexpr size_t WS_W_GLA_IN = 117 * MiB;
constexpr size_t WS_W_GLA_OUT = 141 * MiB;
constexpr size_t WS_W_POOL = 149 * MiB;
constexpr size_t WS_W_FFN_IN = 151 * MiB;
constexpr size_t WS_W_FFN_OUT = 327 * MiB;
constexpr size_t WS_X = 415 * MiB;
constexpr size_t WS_H = 479 * MiB;
constexpr size_t WS_ACT = 543 * MiB;
constexpr size_t WS_FH = WS_ACT + 512 * MiB;
constexpr size_t WS_END = WS_FH + 176 * MiB;
constexpr size_t A_RQ = WS_ACT, A_RK = WS_ACT + 64 * MiB, A_RV = WS_ACT + 128 * MiB, A_RG = WS_ACT + 256 * MiB, A_RO = WS_ACT + 384 * MiB;
constexpr size_t A_CB = WS_ACT, A_CCU = WS_ACT + 64 * MiB, A_CY = WS_ACT + 128 * MiB;
constexpr size_t A_GE = WS_ACT + 448 * MiB;
constexpr size_t A_GQ = WS_ACT, A_GK = WS_ACT + 32 * MiB, A_GV = WS_ACT + 64 * MiB, A_GG = WS_ACT + 128 * MiB, A_GO = WS_ACT + 192 * MiB;
constexpr size_t A_PM = WS_ACT;
constexpr size_t A_FH = WS_FH;
constexpr int CW_TMO = 0, CW_BAR = 4096;

constexpr int RING_BYTES = 131072;
constexpr int LDSCTL_OFF = RING_BYTES, MISC_OFF = LDSCTL_OFF + 320;
constexpr int LDS_BYTES = 147456;

#define GAS __attribute__((address_space(1)))
#define LAS __attribute__((address_space(3)))
typedef unsigned short bf16;
typedef unsigned v4u __attribute__((ext_vector_type(4)));
typedef unsigned v2u __attribute__((ext_vector_type(2)));
typedef float f32x4 __attribute__((ext_vector_type(4)));
typedef GAS unsigned gu32;
#define RLX_AGENT __ATOMIC_RELAXED, __HIP_MEMORY_SCOPE_AGENT
#define LDS_WAIT() asm volatile("s_waitcnt lgkmcnt(0)" ::: "memory")
__device__ __forceinline__ unsigned f2bf(float f) { unsigned u = __builtin_bit_cast(unsigned, f); return (u + 0x7fffu + ((u >> 16) & 1u)) >> 16; }
__device__ __forceinline__ unsigned pk2(float lo, float hi) { return f2bf(lo) | (f2bf(hi) << 16); }
__device__ __forceinline__ v2u pack8_fp8(float a0, float a1, float a2, float a3, float a4, float a5, float a6, float a7, float sc) {
    int lo = __builtin_amdgcn_cvt_pk_fp8_f32(a0 * sc, a1 * sc, 0, false); lo = __builtin_amdgcn_cvt_pk_fp8_f32(a2 * sc, a3 * sc, lo, true);
    int hi = __builtin_amdgcn_cvt_pk_fp8_f32(a4 * sc, a5 * sc, 0, false); hi = __builtin_amdgcn_cvt_pk_fp8_f32(a6 * sc, a7 * sc, hi, true);
    v2u r; r.x = (unsigned)lo; r.y = (unsigned)hi; return r;
}
constexpr float FP8_ASCALE = 4.0f, FP8_WSCALE = 64.0f;
__device__ __forceinline__ float bflo(unsigned w) { return __builtin_bit_cast(float, w << 16); }
__device__ __forceinline__ float bfhi(unsigned w) { return __builtin_bit_cast(float, w & 0xffff0000u); }

__device__ __forceinline__ void unpack8(const v4u& w, float (&f)[8]) { f[0] = bflo(w.x); f[1] = bfhi(w.x); f[2] = bflo(w.y); f[3] = bfhi(w.y); f[4] = bflo(w.z); f[5] = bfhi(w.z); f[6] = bflo(w.w); f[7] = bfhi(w.w); }
#define XB_TMO      128
#define XB_XCNT(j)  (256  + 64 * (j))
#define XB_XSUB(j)  (1280 + 64 * (j))
#define XB_XGEN(j)  (2304 + 64 * (j))
#define XB_TOP      3328
#define XB_TOPGEN   3392
#define XCD_BAR_WORDS 3456
#define XB_GCNT(j)  (3456 + 64 * (j))
#define XB_LATE     4700
#define XB_XTAB     4096
#define XB_SPIN_CAP (1u << 18)
__device__ __forceinline__ unsigned xb_ld(unsigned* p)              { return __hip_atomic_load(p, __ATOMIC_RELAXED, __HIP_MEMORY_SCOPE_AGENT); }
__device__ __forceinline__ unsigned xb_add(unsigned* p, unsigned v) { return __hip_atomic_fetch_add(p, v, __ATOMIC_RELAXED, __HIP_MEMORY_SCOPE_AGENT); }
__device__ __forceinline__ unsigned xb_xcc_id() { return (unsigned)__builtin_amdgcn_s_getreg((3 << 11) | 20) & 0xFu; }
#define XB_SPIN(cond, bar) do { unsigned _sp = 0; while (cond) { __builtin_amdgcn_s_sleep(1); \
    if ((++_sp & 255u) == 0u) { if (xb_ld(&(bar)[XB_TMO])) break; if (_sp > XB_SPIN_CAP) { atomicAdd(&(bar)[XB_TMO], 1u); break; } } } } while (0)
struct XcdBarrier { unsigned* bar; unsigned x; volatile LAS unsigned* st; };
__device__ __forceinline__ XcdBarrier xcd_barrier_post(unsigned* bar, volatile LAS unsigned* st) {
    XcdBarrier b; b.bar = bar; b.x = xb_xcc_id(); b.st = st;
    if (threadIdx.x == 0) { (void)xb_add(&bar[XB_XCNT(b.x)], 1u); __hip_atomic_store(&bar[XB_XTAB + blockIdx.x], b.x + 1u, RLX_AGENT); }
    return b;
}
__device__ __forceinline__ void xcd_barrier_complete(unsigned* bar, unsigned x, unsigned& nloc, unsigned& nx) {
    const unsigned G = gridDim.x * gridDim.y * gridDim.z;
    unsigned sum, cnt, mine, sp = 0u;
    for (;;) {
        sum = 0u; cnt = 0u; mine = 0u;
#pragma unroll
        for (unsigned j = 0; j < 16; ++j) { const unsigned c = xb_ld(&bar[XB_XCNT(j)]); sum += c; cnt += (c > 0u) ? 1u : 0u; mine = (j == x) ? c : mine; }
        if (sum == G) break;
        __builtin_amdgcn_s_sleep(1);
        if ((++sp & 255u) == 0u) { if (xb_ld(&bar[XB_TMO])) break; if (sp > XB_SPIN_CAP) { atomicAdd(&bar[XB_TMO], 1u); break; } }
    }
    nloc = mine > 0u ? mine : 1u; nx = cnt > 0u ? cnt : 1u;
}
__device__ __forceinline__ void xcd_barrier(const XcdBarrier& b, bool global = false) {
    asm volatile("s_waitcnt vmcnt(0)" ::: "memory");
    __syncthreads();
    if (threadIdx.x == 0) {
        unsigned* bar = b.bar;
        __builtin_amdgcn_s_waitcnt(0);
        if (!global && b.st[2] != 0u) {
            const unsigned gen = b.st[3]; b.st[3] = gen + 1u;
            unsigned* gc = &bar[XB_GCNT(blockIdx.x & 7u)];
            (void)xb_add(gc, 1u);
            asm volatile("buffer_inv sc1" ::: "memory");
            XB_SPIN(xb_ld(gc) < 32u * (gen + 1u), bar);
            asm volatile("s_waitcnt vmcnt(0)" ::: "memory");
        } else {
        unsigned nloc = b.st[0], nx = b.st[1];
        if (nloc == 0u) { xcd_barrier_complete(bar, b.x, nloc, nx); b.st[0] = nloc; b.st[1] = nx; }
        const unsigned old = xb_add(&bar[XB_XSUB(b.x)], 1u);
        const unsigned gen = old / nloc;
        if (old + 1u == (gen + 1u) * nloc) {
            __builtin_amdgcn_fence(__ATOMIC_RELEASE, "agent");
            asm volatile("s_waitcnt vmcnt(0)" ::: "memory");
            const unsigned og = xb_add(&bar[XB_TOP], 1u);
            const unsigned tg = og / nx;
            if (og + 1u == (tg + 1u) * nx) xb_add(&bar[XB_TOPGEN], 1u);
            else XB_SPIN(xb_ld(&bar[XB_TOPGEN]) == tg, bar);
            __builtin_amdgcn_fence(__ATOMIC_ACQUIRE, "agent");
            xb_add(&bar[XB_XGEN(b.x)], 1u);
            asm volatile("s_waitcnt vmcnt(0)" ::: "memory");
        } else {
            XB_SPIN(xb_ld(&bar[XB_XGEN(b.x)]) == gen, bar);
            __builtin_amdgcn_fence(__ATOMIC_ACQUIRE, "agent");
            asm volatile("s_waitcnt vmcnt(0)" ::: "memory");
        }
        }
    }
    __syncthreads();
}

__device__ __forceinline__ float wave_sum(float v) {
#pragma unroll
    for (int o = 1; o < 64; o <<= 1) v += __shfl_xor(v, o);
    return v;
}
__device__ __forceinline__ void sincos_acc(float a, float& s, float& c) {
    const double x = (double)a;
    const double n = rint(x * 0.63661977236758134308);
    double r = fma(-n, 1.5707963267948966192, x); r = fma(-n, 6.123233995736766036e-17, r);
    const double r2 = r * r;
    double sp = -2.5052108385441718775e-8; sp = fma(sp, r2, 2.7557319223985890653e-6); sp = fma(sp, r2, -1.9841269841269841270e-4); sp = fma(sp, r2, 8.3333333333333333333e-3); sp = fma(sp, r2, -1.6666666666666666667e-1);
    const double sr = fma(sp * r2, r, r);
    double cp = 2.0876756987868098979e-9; cp = fma(cp, r2, -2.7557319223985890653e-7); cp = fma(cp, r2, 2.4801587301587301587e-5); cp = fma(cp, r2, -1.3888888888888888889e-3); cp = fma(cp, r2, 4.1666666666666666667e-2); cp = fma(cp, r2, -0.5);
    const double cr = fma(cp, r2, 1.0);
    const int q = ((int)n) & 3;
    const double ss = (q & 1) ? cr : sr, cc = (q & 1) ? sr : cr;
    s = (float)((q & 2) ? -ss : ss); c = (float)(((q + 1) & 2) ? -cc : cc);
}

template <bool F8>
__device__ __forceinline__ void transpose_item(const float* W, int ldw, int k0, int srccol0, bf16* WT, int ldt, int dstrow0, LAS float* scr, int lane) {
    float wv[32];
#pragma unroll
    for (int i = 0; i < 32; ++i) wv[i] = W[(size_t)(k0 + 2 * i + (lane >> 5)) * ldw + srccol0 + (lane & 31)];
#pragma unroll
    for (int i = 0; i < 32; ++i) scr[(2 * i + (lane >> 5)) * 33 + (lane & 31)] = wv[i];
    LDS_WAIT(); asm volatile("" ::: "memory");
    const int c = lane & 7;
#pragma unroll
    for (int j = 0; j < 4; ++j) { const int n = (lane >> 3) + 8 * j; const LAS float* s = scr + (8 * c) * 33 + n;
        if constexpr (F8) { *(v2u*)((unsigned char*)WT + (size_t)(dstrow0 + n) * ldt + k0 + 8 * c) = pack8_fp8(s[0 * 33], s[1 * 33], s[2 * 33], s[3 * 33], s[4 * 33], s[5 * 33], s[6 * 33], s[7 * 33], FP8_WSCALE); }
        else { v4u o; o.x = pk2(s[0 * 33], s[1 * 33]); o.y = pk2(s[2 * 33], s[3 * 33]); o.z = pk2(s[4 * 33], s[5 * 33]); o.w = pk2(s[6 * 33], s[7 * 33]);
            *(v4u*)(WT + (size_t)(dstrow0 + n) * ldt + k0 + 8 * c) = o; } }
    LDS_WAIT(); asm volatile("" ::: "memory");
}
struct TJob { const float* src; bf16* dst; int ldw, K, Nd, mode; };
struct Args { const void* in[21]; float* out; unsigned char* ws; int ph_lo, ph_hi; };

__device__ __forceinline__ TJob get_job(const Args& a, int j) {
    unsigned char* ws = a.ws; TJob t;
    if (j == 0)      { t.src = (const float*)a.in[7];  t.dst = (bf16*)(ws + WS_W_RET_IN);  t.ldw = RET_IN;   t.K = D;        t.Nd = RET_IN;   t.mode = 0; }
    else if (j == 1) { t.src = (const float*)a.in[8];  t.dst = (bf16*)(ws + WS_W_RET_OUT); t.ldw = D;        t.K = RET_VW;   t.Nd = D;        t.mode = 0; }
    else if (j == 2) { t.src = (const float*)a.in[9];  t.dst = (bf16*)(ws + WS_W_CONV_IN); t.ldw = CONV_INW; t.K = D;        t.Nd = CONV_INW; t.mode = 2; }
    else if (j == 3) { t.src = (const float*)a.in[11]; t.dst = (bf16*)(ws + WS_W_CONV_OUT); t.ldw = D;       t.K = D;        t.Nd = D;        t.mode = 0; }
    else if (j == 4) { t.src = (const float*)a.in[12]; t.dst = (bf16*)(ws + WS_W_GLA_IN);  t.ldw = GLA_INW;  t.K = D;        t.Nd = GLA_MAIN; t.mode = 0; }
    else if (j == 5) { t.src = (const float*)a.in[15]; t.dst = (bf16*)(ws + WS_W_GLA_OUT); t.ldw = D;        t.K = D;        t.Nd = D;        t.mode = 0; }
    else if (j < 10) { const int g = j - 6;  t.src = (const float*)a.in[16] + (size_t)g * 512 * 512; t.dst = (bf16*)(ws + WS_W_POOL) + (size_t)g * 512 * 512; t.ldw = 512; t.K = 512; t.Nd = 512; t.mode = 0; }
    else if (j < 14) { const int l = j - 10; t.src = (const float*)a.in[18] + (size_t)l * D * FF2;   t.dst = (bf16*)(ws + WS_W_FFN_IN) + (size_t)l * FF2 * D;  t.ldw = FF2; t.K = D;   t.Nd = FF2; t.mode = 1; }
    else             { const int l = j - 14; t.src = (const float*)a.in[19] + (size_t)l * FF * D;    t.dst = (bf16*)(ws + WS_W_FFN_OUT) + (size_t)l * D * FF;  t.ldw = D;   t.K = FF;  t.Nd = D;   t.mode = 0; }
    return t;
}
constexpr int NJOBS = 18;
__device__ __forceinline__ int job_src_col(int mode, int n) {
    if (mode == 1) { const int tile = n >> 8, r = n & 255; return r < 128 ? tile * 128 + r : FF + tile * 128 + (r - 128); }
    if (mode == 2) { if (n < 2048) return n; const int nn = n - 2048, tile = nn >> 8, r = nn & 255; return r < 128 ? 2048 + tile * 128 + r : 4096 + tile * 128 + (r - 128); }
    return n;
}

__device__ __forceinline__ void transposes_masked(const Args& a, LAS unsigned char* lds, int lane, int wave, unsigned mask, int wid, int nw) {
    LAS float* scr = (LAS float*)(lds + wave * 16384);
    int base = 0;
    for (int j = 0; j < NJOBS; ++j) {
        if (!((mask >> j) & 1u)) continue;
        const TJob t = get_job(a, j);
        const int nblk = t.Nd / 32, nitems = (t.K / 64) * nblk;
        int it = base + ((wid - base % nw) + nw) % nw;
        const bool f8 = (j >= 10 && j < 14) && ((FP8_FFN_MASK >> (j - 10)) & 1);
        for (; it < base + nitems; it += nw) { const int r = it - base, kb = r / nblk, nb = r % nblk;
            if (f8) transpose_item<true>(t.src, t.ldw, kb * 64, job_src_col(t.mode, nb * 32), t.dst, t.K, nb * 32, scr, lane);
            else transpose_item<false>(t.src, t.ldw, kb * 64, job_src_col(t.mode, nb * 32), t.dst, t.K, nb * 32, scr, lane); }
        base += nitems;
    }
}
constexpr unsigned ALL_JOBS = (1u << NJOBS) - 1u;
constexpr unsigned LATE_JOBS = (0xFu << 6) | (1u << 13) | (1u << 17) | (1u << 16) | (1u << 12);

__device__ __forceinline__ void prologue_phase(const Args& a, LAS unsigned char* lds, int tid, int lane, int wave, int vcu, int G, bool late_w) {
    unsigned char* ws = a.ws;
    {
        LAS float* cact = (LAS float*)lds;
        LAS float* red = (LAS float*)(lds + 65536);
        const float* c = (const float*)a.in[1];
        for (int i = tid; i < 8 * 2048; i += 512) { const int b = i >> 11, k = i & 2047; const float v = c[i]; cact[k * 8 + b] = v / (1.0f + __expf(-v)); }
        __syncthreads();
        const float* wmod = (const float*)a.in[3]; const float* bmod = (const float*)a.in[4]; float* mod = (float*)(ws + WS_MOD);
        for (int item = vcu; item < 4 * 48; item += G) {
            const int l = item / 48, n0 = (item % 48) * 256;
            const float* W = wmod + (size_t)l * D * MODW + n0 + 4 * lane;
            f32x4 acc[8];
#pragma unroll
            for (int b = 0; b < 8; ++b) acc[b] = (f32x4){0.f, 0.f, 0.f, 0.f};
            for (int kk = 0; kk < 256; kk += 8) {
                f32x4 w[8];
#pragma unroll
                for (int u = 0; u < 8; ++u) w[u] = *(const f32x4*)(W + (size_t)(wave * 256 + kk + u) * MODW);
#pragma unroll
                for (int u = 0; u < 8; ++u) { const int k = wave * 256 + kk + u; const f32x4 c0 = *(const LAS f32x4*)(cact + k * 8), c1 = *(const LAS f32x4*)(cact + k * 8 + 4);
                    acc[0] += w[u] * c0[0]; acc[1] += w[u] * c0[1]; acc[2] += w[u] * c0[2]; acc[3] += w[u] * c0[3];
                    acc[4] += w[u] * c1[0]; acc[5] += w[u] * c1[1]; acc[6] += w[u] * c1[2]; acc[7] += w[u] * c1[3]; }
            }
#pragma unroll
            for (int b = 0; b < 8; ++b) *(LAS f32x4*)(red + (wave * 8 + b) * 256 + 4 * lane) = acc[b];
            __syncthreads();
            { const int b = tid >> 6; f32x4 s = *(const f32x4*)(bmod + (size_t)l * MODW + n0 + 4 * lane);
#pragma unroll
              for (int w = 0; w < 8; ++w) s += *(const LAS f32x4*)(red + (w * 8 + b) * 256 + 4 * lane);
              *(f32x4*)(mod + (size_t)(l * 8 + b) * MODW + n0 + 4 * lane) = s; }
            __syncthreads();
        }
        __syncthreads();
    }
    const int gw = vcu * NWAVES + wave, NGW = G * NWAVES;
    transposes_masked(a, lds, lane, wave, late_w ? (ALL_JOBS & ~LATE_JOBS) : ALL_JOBS, gw, NGW);
    const int gtid = vcu * 512 + tid, NT = G * 512;
    { const float* w = (const float*)a.in[12]; float* wzt = (float*)(ws + WS_WZT);
      for (int i = gtid; i < 16 * 2048; i += NT) { const int r = i >> 11, k = i & 2047; wzt[i] = w[(size_t)k * GLA_INW + GLA_MAIN + r]; } }
    { const int* pos = (const int*)a.in[2]; float* ct = (float*)(ws + WS_COS); float* st = (float*)(ws + WS_SIN);
      for (int i = gtid; i < M * 128; i += NT) { const int m = i >> 7, j = i & 127;
          const float lin = (float)j * (1.0f / 127.0f); const float inv = exp2f(-lin * 13.287712379549449f);
          const float ang = (float)pos[m] * inv; float s, c; sincos_acc(ang, s, c); ct[i] = c; st[i] = s; } }
}

__device__ __forceinline__ float reduce16(const float (&p)[16], int lane) {
    float a[8], b[4], c[2];
    { const bool hi = (lane & 32) != 0;
#pragma unroll
      for (int k = 0; k < 8; ++k) { const float send = hi ? p[k] : p[k + 8], keep = hi ? p[k + 8] : p[k]; a[k] = keep + __shfl_xor(send, 32); } }
    { const bool hi = (lane & 16) != 0;
#pragma unroll
      for (int k = 0; k < 4; ++k) { const float send = hi ? a[k] : a[k + 4], keep = hi ? a[k + 4] : a[k]; b[k] = keep + __shfl_xor(send, 16); } }
    { const bool hi = (lane & 8) != 0;
#pragma unroll
      for (int k = 0; k < 2; ++k) { const float send = hi ? b[k] : b[k + 2], keep = hi ? b[k + 2] : b[k]; c[k] = keep + __shfl_xor(send, 8); } }
    const bool hi4 = (lane & 4) != 0; const float send = hi4 ? c[0] : c[1], keep = hi4 ? c[1] : c[0];
    float d = keep + __shfl_xor(send, 4);
    d += __shfl_xor(d, 2); d += __shfl_xor(d, 1);
    return d;
}
template <bool ZP, bool XF32, bool OUT8 = false>
__device__ __forceinline__ void norm_phase(LAS unsigned char* lds, const void* xin, const float* gain, const float* sh, const float* sc, bf16* hout, const float* wzt, float* zout, int lane, int wave, int vcu, int G) {
    const int gw = vcu * NWAVES + wave, NGW = G * NWAVES;
    LAS float* wl = (LAS float*)lds;
    if constexpr (ZP) {
        for (int i = threadIdx.x; i < 8192; i += NWAVES * 64) { const int ln = i & 63, half = (i >> 6) & 1, j = (i >> 7) & 3, rr = i >> 9;
            *(LAS f32x4*)(wl + i * 4) = *(const f32x4*)(wzt + (size_t)rr * D + 512 * j + 8 * ln + 4 * half); }
        __syncthreads();
    }
    const bool xdeal = (G == 256);
    const int nit = xdeal ? 4 : (M + 2 * NGW - 1) / (2 * NGW);
    for (int it_ = 0; it_ < nit; ++it_) {
        const int m0 = xdeal ? 2048 * (gw >> 8) + 2 * (gw & 255) + 512 * it_ : 2 * gw + it_ * 2 * NGW;
        if (m0 >= M) break;
        f32x4 v[2][4][2]; float ss[2] = {0.f, 0.f};
#pragma unroll
        for (int r = 0; r < 2; ++r)
#pragma unroll
            for (int j = 0; j < 4; ++j) {
                if constexpr (XF32) { const float* xr = (const float*)xin + (size_t)(m0 + r) * D + 8 * lane; v[r][j][0] = *(const f32x4*)(xr + 512 * j); v[r][j][1] = *(const f32x4*)(xr + 512 * j + 4); }
                else { float f[8]; unpack8(*(const v4u*)((const bf16*)xin + (size_t)(m0 + r) * D + 8 * lane + 512 * j), f); v[r][j][0] = (f32x4){f[0], f[1], f[2], f[3]}; v[r][j][1] = (f32x4){f[4], f[5], f[6], f[7]}; } }
#pragma unroll
        for (int r = 0; r < 2; ++r)
#pragma unroll
            for (int j = 0; j < 4; ++j)
#pragma unroll
                for (int e = 0; e < 4; ++e) ss[r] += v[r][j][0][e] * v[r][j][0][e] + v[r][j][1][e] * v[r][j][1][e];
#pragma unroll
        for (int r = 0; r < 2; ++r) { const int m = m0 + r, b = m >> 11;
            const float rstd = rsqrtf(wave_sum(ss[r]) * (1.0f / D) + EPS);
#pragma unroll
            for (int j = 0; j < 4; ++j) { const int col = 512 * j + 8 * lane;
#pragma unroll
                for (int q = 0; q < 2; ++q) { const f32x4 gg = *(const f32x4*)(gain + col + 4 * q), s1 = *(const f32x4*)(sc + (size_t)b * MODW + col + 4 * q), s0 = *(const f32x4*)(sh + (size_t)b * MODW + col + 4 * q);
                    v[r][j][q] = (v[r][j][q] * rstd * gg) * (s1 + 1.0f) + s0; }
                if constexpr (OUT8) { *(v2u*)((unsigned char*)hout + (size_t)m * D + col) = pack8_fp8(v[r][j][0][0], v[r][j][0][1], v[r][j][0][2], v[r][j][0][3], v[r][j][1][0], v[r][j][1][1], v[r][j][1][2], v[r][j][1][3], FP8_ASCALE); }
                else { v4u o; o.x = pk2(v[r][j][0][0], v[r][j][0][1]); o.y = pk2(v[r][j][0][2], v[r][j][0][3]); o.z = pk2(v[r][j][1][0], v[r][j][1][1]); o.w = pk2(v[r][j][1][2], v[r][j][1][3]);
                    *(v4u*)(hout + (size_t)m * D + col) = o; } }
        }
        if constexpr (ZP) {
            float p0[16], p1[16];
#pragma unroll
            for (int rr = 0; rr < 16; ++rr) { p0[rr] = 0.f; p1[rr] = 0.f;
#pragma unroll
                for (int j = 0; j < 4; ++j) { const f32x4 w0 = *(const LAS f32x4*)(wl + (((rr * 4 + j) * 2 + 0) * 64 + lane) * 4), w1 = *(const LAS f32x4*)(wl + (((rr * 4 + j) * 2 + 1) * 64 + lane) * 4);
#pragma unroll
                    for (int e = 0; e < 4; ++e) { p0[rr] += v[0][j][0][e] * w0[e] + v[0][j][1][e] * w1[e]; p1[rr] += v[1][j][0][e] * w0[e] + v[1][j][1][e] * w1[e]; } } }
            const float z0 = reduce16(p0, lane), z1 = reduce16(p1, lane);
            if ((lane & 3) == 0) { const int rr = ((lane >> 5) & 1) * 8 + ((lane >> 4) & 1) * 4 + ((lane >> 3) & 1) * 2 + ((lane >> 2) & 1);
                zout[(size_t)m0 * 16 + rr] = z0; zout[(size_t)(m0 + 1) * 16 + rr] = z1; }
        }
    }
}
__device__ __forceinline__ void final_norm_phase(const bf16* xin, const float* gain, float* out, int lane, int wave, int vcu, int G) {
    const int gw = vcu * NWAVES + wave, NGW = G * NWAVES;
    const bool xdeal = (G == 256);
    const int nit = xdeal ? 4 : (M + 2 * NGW - 1) / (2 * NGW);
    for (int it_ = 0; it_ < nit; ++it_) {
        const int m0 = xdeal ? 2048 * (gw >> 8) + 2 * (gw & 255) + 512 * it_ : 2 * gw + it_ * 2 * NGW;
        if (m0 >= M) break;
        float v[2][4][8]; float ss[2] = {0.f, 0.f};
#pragma unroll
        for (int r = 0; r < 2; ++r)
#pragma unroll
            for (int j = 0; j < 4; ++j) unpack8(*(const v4u*)(xin + (size_t)(m0 + r) * D + 8 * lane + 512 * j), v[r][j]);
#pragma unroll
        for (int r = 0; r < 2; ++r)
#pragma unroll
            for (int j = 0; j < 4; ++j)
#pragma unroll
                for (int e = 0; e < 8; ++e) ss[r] += v[r][j][e] * v[r][j][e];
#pragma unroll
        for (int r = 0; r < 2; ++r) { const int m = m0 + r;
            const float rstd = rsqrtf(wave_sum(ss[r]) * (1.0f / D) + EPS);
#pragma unroll
            for (int j = 0; j < 4; ++j) { const int col = 512 * j + 8 * lane; const f32x4 g0 = *(const f32x4*)(gain + col), g1 = *(const f32x4*)(gain + col + 4);
                *(f32x4*)(out + (size_t)m * D + col) = (f32x4){v[r][j][0], v[r][j][1], v[r][j][2], v[r][j][3]} * rstd * g0;
                *(f32x4*)(out + (size_t)m * D + col + 4) = (f32x4){v[r][j][4], v[r][j][5], v[r][j][6], v[r][j][7]} * rstd * g1; } }
    }
}
__device__ __forceinline__ void post_phase(bf16* O, const bf16* Gt, int nheads, int lane, int wave, int vcu, int G) {
    const int gw = vcu * NWAVES + wave, NGW = G * NWAVES, nitems = M * nheads;
    const bool xdeal = (G == 256);
    const int nit = xdeal ? 2 * nheads : (nitems + 4 * NGW - 1) / (4 * NGW);
    for (int it_ = 0; it_ < nit; ++it_) {
        const int it0 = xdeal ? (gw >> 8) * SEQ * nheads + 4 * (gw & 255) + 1024 * it_ : 4 * gw + it_ * 4 * NGW;
        if (it0 >= nitems) break;
        v4u ov[4], gv[4];
#pragma unroll
        for (int u = 0; u < 4; ++u) { const size_t off = (size_t)(it0 + u) * 512 + 8 * lane; ov[u] = *(const v4u*)(O + off); gv[u] = *(const v4u*)(Gt + off); }
#pragma unroll
        for (int u = 0; u < 4; ++u) { const size_t off = (size_t)(it0 + u) * 512 + 8 * lane;
            float o[8], g[8]; unpack8(ov[u], o); unpack8(gv[u], g);
            float ss = 0.f;
#pragma unroll
            for (int e = 0; e < 8; ++e) ss += o[e] * o[e];
            const float rstd = rsqrtf(wave_sum(ss) * (1.0f / 512.0f) + EPS);
            v4u w; w.x = pk2(g[0] * o[0] * rstd, g[1] * o[1] * rstd); w.y = pk2(g[2] * o[2] * rstd, g[3] * o[3] * rstd); w.z = pk2(g[4] * o[4] * rstd, g[5] * o[5] * rstd); w.w = pk2(g[6] * o[6] * rstd, g[7] * o[7] * rstd);
            *(v4u*)(O + off) = w; }
    }
}
__device__ __forceinline__ void conv_phase(const bf16* Bg, const bf16* CU, bf16* Y, const float* cw, int tid, int vcu, int G) {
    const int gtid = vcu * 512 + tid, NT = G * 512;
    for (int task = gtid; task < 256 * 512; task += NT) {
        const int cg = task & 255, run = task >> 8, m0 = run * 32, col = cg * 8;
        float w0[8], w1[8], w2[8], p2[8], p1[8];
#pragma unroll
        for (int e = 0; e < 8; ++e) { w0[e] = cw[col + e]; w1[e] = cw[D + col + e]; w2[e] = cw[2 * D + col + e]; p2[e] = 0.f; p1[e] = 0.f; }
        if ((m0 & (SEQ - 1)) != 0) { unpack8(*(const v4u*)(CU + (size_t)(m0 - 2) * D + col), p2); unpack8(*(const v4u*)(CU + (size_t)(m0 - 1) * D + col), p1); }
        for (int r0 = 0; r0 < 32; r0 += 8) { v4u cw[8], bw[8];
#pragma unroll
            for (int u = 0; u < 8; ++u) { const size_t off = (size_t)(m0 + r0 + u) * D + col; cw[u] = *(const v4u*)(CU + off); bw[u] = *(const v4u*)(Bg + off); }
#pragma unroll
            for (int u = 0; u < 8; ++u) { const size_t off = (size_t)(m0 + r0 + u) * D + col;
                float cu[8], bg[8], y[8]; unpack8(cw[u], cu); unpack8(bw[u], bg);
#pragma unroll
                for (int e = 0; e < 8; ++e) { y[e] = bg[e] * (w0[e] * p2[e] + w1[e] * p1[e] + w2[e] * cu[e]); p2[e] = p1[e]; p1[e] = cu[e]; }
                v4u w; w.x = pk2(y[0], y[1]); w.y = pk2(y[2], y[3]); w.z = pk2(y[4], y[5]); w.w = pk2(y[6], y[7]);
                *(v4u*)(Y + off) = w; } }
    }
}
__device__ __forceinline__ void pool_phase(const bf16* H, bf16* MX, int tid, int vcu, int G) {
    const int gtid = vcu * 512 + tid, NT = G * 512;
    for (int task = gtid; task < 256 * 512; task += NT) {
        const int cg = task & 255, run = task >> 8, m0 = run * 32, col = cg * 8, win = 2 << (cg >> 6), t0 = m0 & (SEQ - 1);
        const bf16* hp = H + (size_t)m0 * D + col;
        float sum[8];
#pragma unroll
        for (int e = 0; e < 8; ++e) sum[e] = 0.f;
        if (t0 != 0) {
            v4u pw[16];
#pragma unroll
            for (int j = 0; j < 16; ++j) pw[j] = (j < win) ? *(const v4u*)(hp - (ptrdiff_t)(j + 1) * D) : (v4u){0u, 0u, 0u, 0u};
#pragma unroll
            for (int j = 0; j < 16; ++j) { float f[8]; unpack8(pw[j], f);
#pragma unroll
                for (int e = 0; e < 8; ++e) sum[e] += f[e]; }
        }
        for (int r0 = 0; r0 < 32; r0 += 8) {
            v4u cw[8], ow[8];
#pragma unroll
            for (int u = 0; u < 8; ++u) { const int r = r0 + u; cw[u] = *(const v4u*)(hp + (size_t)r * D);
                ow[u] = (t0 + r - win >= 0) ? *(const v4u*)(hp + (ptrdiff_t)(r - win) * D) : (v4u){0u, 0u, 0u, 0u}; }
#pragma unroll
            for (int u = 0; u < 8; ++u) { const int r = r0 + u, t = t0 + r; const int cnt = (t + 1 < win) ? t + 1 : win;
                float cur[8], old[8], y[8]; unpack8(cw[u], cur); unpack8(ow[u], old);
                const float inv = 1.0f / (float)cnt;
#pragma unroll
                for (int e = 0; e < 8; ++e) { sum[e] += cur[e] - old[e]; y[e] = sum[e] * inv - cur[e]; }
                v4u w; w.x = pk2(y[0], y[1]); w.y = pk2(y[2], y[3]); w.z = pk2(y[4], y[5]); w.w = pk2(y[6], y[7]);
                *(v4u*)(MX + (size_t)(m0 + r) * D + col) = w; }
        }
    }
}

typedef short s16x4 __attribute__((ext_vector_type(4)));
typedef short bf16x8s __attribute__((ext_vector_type(8)));
typedef float f32x2s __attribute__((ext_vector_type(2)));
typedef __bf16 bf16x2_t __attribute__((ext_vector_type(2)));
__device__ __forceinline__ unsigned cvt2(float a, float b) { f32x2s v = {a, b}; bf16x2_t r = __builtin_convertvector(v, bf16x2_t); return __builtin_bit_cast(unsigned, r); }
__device__ __forceinline__ s16x4 ldtr(LAS const unsigned char* p) { return __builtin_bit_cast(s16x4, __builtin_amdgcn_ds_read_tr16_b64_v4i16((LAS s16x4*)p)); }
constexpr int SC_QS = 528, SC_KS = 544, SC_VS = 288, SC_PS = 160, SC_OS = 272;
constexpr int SC_QI = 0, SC_KI = SC_QI + 64 * SC_QS, SC_VI = SC_KI + 64 * SC_KS, SC_PI = SC_VI + 64 * SC_VS, SC_OI = SC_PI + 64 * SC_PS, SC_EI = SC_OI + 64 * SC_OS, SC_END = SC_EI + 1024;
static_assert(SC_END <= RING_BYTES, "scan LDS map");
#define SC_BAR() do { asm volatile("s_waitcnt lgkmcnt(0)" ::: "memory"); __builtin_amdgcn_s_barrier(); asm volatile("" ::: "memory"); } while (0)
template <bool GLA>
__device__ __forceinline__ void scan_item2(LAS unsigned char* lds, const bf16* Qd, const bf16* Kd, const bf16* V, bf16* O, const float* EG, int ldqk, int ldv, int b, int h, int dvs, float e_const, int tid) {
    const int lane = tid & 63, w = __builtin_amdgcn_readfirstlane(tid >> 6), fr = lane & 15, fq = lane >> 4, q4 = fr >> 2, p4 = fr & 3;
    if (w >= 4) {
        const int t2 = tid - 256, cw = w - 4;
        const bf16* qg = Qd + (size_t)(b * SEQ + (t2 >> 5)) * ldqk + h * 256 + (t2 & 31) * 8;
        const bf16* kg = Kd + (size_t)(b * SEQ + (t2 >> 5)) * ldqk + h * 256 + (t2 & 31) * 8;
        const bf16* vg = V + (size_t)(b * SEQ + (t2 >> 4)) * ldv + h * 512 + dvs * 128 + (t2 & 15) * 8;
        const float* eg = GLA ? EG + (size_t)(b * 32) * 1024 + h * 256 + (t2 & 63) * 4 : nullptr;
        LAS unsigned char* qw = lds + SC_QI + (t2 >> 5) * SC_QS + (t2 & 31) * 16;
        LAS unsigned char* kw = lds + SC_KI + (t2 >> 5) * SC_KS + (t2 & 31) * 16;
        LAS unsigned char* vw = lds + SC_VI + (t2 >> 4) * SC_VS + (t2 & 15) * 16;
        v4u qr[8], kr[8], vr[4]; f32x4 er = (f32x4){0.f, 0.f, 0.f, 0.f};
#pragma unroll
        for (int k = 0; k < 8; ++k) { qr[k] = *(const v4u*)(qg + (size_t)(8 * k) * ldqk); kr[k] = *(const v4u*)(kg + (size_t)(8 * k) * ldqk); }
#pragma unroll
        for (int k = 0; k < 4; ++k) vr[k] = *(const v4u*)(vg + (size_t)(16 * k) * ldv);
        if (GLA && t2 < 64) er = *(const f32x4*)eg;
        for (int c = 0; c < SEQ / 64; ++c) {
#pragma unroll
            for (int k = 0; k < 8; ++k) { *(LAS v4u*)(qw + 8 * k * SC_QS) = qr[k]; *(LAS v4u*)(kw + 8 * k * SC_KS) = kr[k]; }
#pragma unroll
            for (int k = 0; k < 4; ++k) *(LAS v4u*)(vw + 16 * k * SC_VS) = vr[k];
            if (GLA && t2 < 64) *(LAS f32x4*)(lds + SC_EI + t2 * 16) = er;
            SC_BAR();
            if (c + 1 < SEQ / 64) { const size_t adv = (size_t)(c + 1) * 64;
#pragma unroll
                for (int k = 0; k < 8; ++k) { qr[k] = *(const v4u*)(qg + (adv + 8 * k) * ldqk); kr[k] = *(const v4u*)(kg + (adv + 8 * k) * ldqk); }
#pragma unroll
                for (int k = 0; k < 4; ++k) vr[k] = *(const v4u*)(vg + (adv + 16 * k) * ldv);
                if (GLA && t2 < 64) er = *(const f32x4*)(eg + (size_t)(c + 1) * 1024); }
            f32x4 sa[4];
#pragma unroll
            for (int tj = 0; tj < 4; ++tj) sa[tj] = (f32x4){0.f, 0.f, 0.f, 0.f};
            bf16x8s fbq[3], fak[3][4];
#define LD_S(buf, ks) do { fbq[buf] = *(const LAS bf16x8s*)(lds + SC_QI + (16 * cw + fr) * SC_QS + (32 * (ks) + 8 * fq) * 2); \
                _Pragma("unroll") for (int tj = 0; tj < 4; ++tj) fak[buf][tj] = *(const LAS bf16x8s*)(lds + SC_KI + (16 * tj + fr) * SC_KS + (32 * (ks) + 8 * fq) * 2); } while (0)
            LD_S(0, 0); LD_S(1, 1); LD_S(2, 2);
#pragma unroll
            for (int ks = 0; ks < 8; ++ks) {
                __builtin_amdgcn_sched_barrier(0);
#pragma unroll
                for (int tj = 0; tj < 4; ++tj) sa[tj] = __builtin_amdgcn_mfma_f32_16x16x32_bf16(fak[ks % 3][tj], fbq[ks % 3], sa[tj], 0, 0, 0);
                __builtin_amdgcn_sched_barrier(0);
                if (ks + 3 < 8) LD_S(ks % 3, ks + 3);
            }
#undef LD_S
            { const int i = 16 * cw + fr;
#pragma unroll
              for (int tj = 0; tj < 4; ++tj) { const int j0 = 16 * tj + 4 * fq;
                  const float p0 = (j0 + 0 <= i) ? sa[tj][0] : 0.f, p1 = (j0 + 1 <= i) ? sa[tj][1] : 0.f, p2 = (j0 + 2 <= i) ? sa[tj][2] : 0.f, p3 = (j0 + 3 <= i) ? sa[tj][3] : 0.f;
                  v2u pw; pw.x = cvt2(p0, p1); pw.y = cvt2(p2, p3);
                  *(LAS v2u*)(lds + SC_PI + i * SC_PS + j0 * 2) = pw; } }
            SC_BAR();
        }
        SC_BAR();
    } else {
        f32x4 st[16][2];
#pragma unroll
        for (int t = 0; t < 16; ++t) { st[t][0] = (f32x4){0.f, 0.f, 0.f, 0.f}; st[t][1] = (f32x4){0.f, 0.f, 0.f, 0.f}; }
        bf16* const obase = O + (size_t)(b * SEQ) * ldv + h * 512 + dvs * 128 + 32 * w;
        const unsigned ooff = (unsigned)(fr * ldv + 4 * fq) * 2u;
        for (int c = 0; c < SEQ / 64; ++c) {
            SC_BAR();
            f32x4 oa[4][2];
#pragma unroll
            for (int ti = 0; ti < 4; ++ti) { oa[ti][0] = (f32x4){0.f, 0.f, 0.f, 0.f}; oa[ti][1] = (f32x4){0.f, 0.f, 0.f, 0.f}; }
            v2u faq[2][4][2];
#define LD_C1(buf, s_) do { _Pragma("unroll") for (int ti = 0; ti < 4; ++ti) { LAS const unsigned char* ap_ = lds + SC_QI + (16 * ti + fr) * SC_QS + (32 * (s_) + 4 * fq) * 2; \
                faq[buf][ti][0] = *(const LAS v2u*)ap_; faq[buf][ti][1] = *(const LAS v2u*)(ap_ + 32); } } while (0)
            s16x4 fkt[3][2][2]; bf16x8s bv[2][2];
#define LD_C2(buf, g) do { const int ks_ = (g) >> 3, t0_ = 2 * ((g) & 7); _Pragma("unroll") for (int t = 0; t < 2; ++t) { \
                fkt[buf][t][0] = ldtr(lds + SC_KI + (32 * ks_ + 8 * fq + q4) * SC_KS + (16 * (t0_ + t) + 4 * p4) * 2); \
                fkt[buf][t][1] = ldtr(lds + SC_KI + (32 * ks_ + 8 * fq + 4 + q4) * SC_KS + (16 * (t0_ + t) + 4 * p4) * 2); } } while (0)
            LD_C1(0, 0);
#pragma unroll
            for (int s_ = 0; s_ < 8; ++s_) {
                if (s_ + 1 < 8) LD_C1((s_ + 1) & 1, s_ + 1); else { LD_C2(0, 0); LD_C2(1, 1); }
                __builtin_amdgcn_sched_barrier(0);
#pragma unroll
                for (int ct = 0; ct < 2; ++ct) {
                    v4u sbw; sbw.x = cvt2(st[2 * s_][ct][0], st[2 * s_][ct][1]); sbw.y = cvt2(st[2 * s_][ct][2], st[2 * s_][ct][3]); sbw.z = cvt2(st[2 * s_ + 1][ct][0], st[2 * s_ + 1][ct][1]); sbw.w = cvt2(st[2 * s_ + 1][ct][2], st[2 * s_ + 1][ct][3]);
                    const bf16x8s sb = __builtin_bit_cast(bf16x8s, sbw);
#pragma unroll
                    for (int ti = 0; ti < 4; ++ti) { v4u aw; aw.x = faq[s_ & 1][ti][0].x; aw.y = faq[s_ & 1][ti][0].y; aw.z = faq[s_ & 1][ti][1].x; aw.w = faq[s_ & 1][ti][1].y;
                        oa[ti][ct] = __builtin_amdgcn_mfma_f32_16x16x32_bf16(sb, __builtin_bit_cast(bf16x8s, aw), oa[ti][ct], 0, 0, 0); } }
                __builtin_amdgcn_sched_barrier(0);
            }
#pragma unroll
            for (int ks = 0; ks < 2; ++ks)
#pragma unroll
                for (int ct = 0; ct < 2; ++ct) { const s16x4 lo = ldtr(lds + SC_VI + (32 * ks + 8 * fq + q4) * SC_VS + (32 * w + 16 * ct + 4 * p4) * 2), hi = ldtr(lds + SC_VI + (32 * ks + 8 * fq + 4 + q4) * SC_VS + (32 * w + 16 * ct + 4 * p4) * 2);
                    bv[ks][ct] = __builtin_shufflevector(lo, hi, 0, 1, 2, 3, 4, 5, 6, 7); }
#pragma unroll
            for (int g = 0; g < 16; ++g) {
                if (g + 2 < 16) LD_C2((g + 2) % 3, g + 2);
                __builtin_amdgcn_sched_barrier(0);
#pragma unroll
                for (int t = 0; t < 2; ++t) { const bf16x8s ak = __builtin_shufflevector(fkt[g % 3][t][0], fkt[g % 3][t][1], 0, 1, 2, 3, 4, 5, 6, 7);
#pragma unroll
                    for (int ct = 0; ct < 2; ++ct) st[2 * (g & 7) + t][ct] = __builtin_amdgcn_mfma_f32_16x16x32_bf16(ak, bv[g >> 3][ct], st[2 * (g & 7) + t][ct], 0, 0, 0); }
                __builtin_amdgcn_sched_barrier(0);
            }
#undef LD_C1
#undef LD_C2
#pragma unroll
            for (int t = 0; t < 16; ++t) { if (GLA) { const f32x4 e4 = *(const LAS f32x4*)(lds + SC_EI + (16 * t + 4 * fq) * 4); st[t][0] = st[t][0] * e4; st[t][1] = st[t][1] * e4; } else { st[t][0] = st[t][0] * e_const; st[t][1] = st[t][1] * e_const; } }
            SC_BAR();
#pragma unroll
            for (int ks = 0; ks < 2; ++ks) { bf16x8s ap[4];
#pragma unroll
                for (int ti = 0; ti < 4; ++ti) ap[ti] = *(const LAS bf16x8s*)(lds + SC_PI + (16 * ti + fr) * SC_PS + (32 * ks + 8 * fq) * 2);
#pragma unroll
                for (int ti = 0; ti < 4; ++ti)
#pragma unroll
                    for (int ct = 0; ct < 2; ++ct) oa[ti][ct] = __builtin_amdgcn_mfma_f32_16x16x32_bf16(bv[ks][ct], ap[ti], oa[ti][ct], 0, 0, 0); }
#pragma unroll
            for (int ti = 0; ti < 4; ++ti)
#pragma unroll
                for (int ct = 0; ct < 2; ++ct) { v2u ow; ow.x = cvt2(oa[ti][ct][0], oa[ti][ct][1]); ow.y = cvt2(oa[ti][ct][2], oa[ti][ct][3]);
                    *(v2u*)((char*)(obase + ((size_t)c * 64 + 16 * ti) * ldv + 16 * ct) + ooff) = ow; }
        }
        SC_BAR();
    }
}
__device__ __forceinline__ void gla_prep_item(LAS unsigned char* lds, bf16* Q, bf16* Kb, const float* Z, const float* Wg, const float* bgate, float* EG, int item, int tid) {
    const int m0 = item * 64;
    LAS float* zs = (LAS float*)lds;
    zs[tid] = Z[(size_t)m0 * 16 + tid]; zs[tid + 512] = Z[(size_t)m0 * 16 + tid + 512];
    __syncthreads();
    const int n = 2 * tid;
    float wg0[16], wg1[16];
#pragma unroll
    for (int r = 0; r < 16; ++r) { const f32x2s wv = *(const f32x2s*)(Wg + r * GLA_QK + n); wg0[r] = wv[0]; wg1[r] = wv[1]; }
    const float bg0 = bgate[n], bg1 = bgate[n + 1];
    float b0 = 0.f, b1 = 0.f;
    unsigned* qp = (unsigned*)(Q + (size_t)m0 * GLA_QK + n); unsigned* kp = (unsigned*)(Kb + (size_t)m0 * GLA_QK + n);
    for (int t0 = 0; t0 < 64; t0 += 8) {
        unsigned qv[8], kv[8];
#pragma unroll
        for (int u = 0; u < 8; ++u) { qv[u] = qp[(size_t)(t0 + u) * (GLA_QK / 2)]; kv[u] = kp[(size_t)(t0 + u) * (GLA_QK / 2)]; }
#pragma unroll
        for (int u = 0; u < 8; ++u) { const int t = t0 + u; float x0 = bg0, x1 = bg1;
#pragma unroll
            for (int r4 = 0; r4 < 4; ++r4) { const f32x4 z4 = *(const LAS f32x4*)(zs + t * 16 + r4 * 4);
#pragma unroll
                for (int e = 0; e < 4; ++e) { x0 = fmaf(z4[e], wg0[4 * r4 + e], x0); x1 = fmaf(z4[e], wg1[4 * r4 + e], x1); } }
            b0 += (fminf(x0, 0.f) - __logf(1.0f + __expf(-fabsf(x0)))) * 0.0625f;
            b1 += (fminf(x1, 0.f) - __logf(1.0f + __expf(-fabsf(x1)))) * 0.0625f;
            const float e0 = __expf(b0), e1 = __expf(b1), i0 = __expf(-b0), i1 = __expf(-b1);
            qp[(size_t)t * (GLA_QK / 2)] = cvt2(bflo(qv[u]) * e0, bfhi(qv[u]) * e1);
            kp[(size_t)t * (GLA_QK / 2)] = cvt2(bflo(kv[u]) * i0, bfhi(kv[u]) * i1); }
    }
    *(f32x2s*)(EG + (size_t)item * GLA_QK + n) = (f32x2s){__expf(b0), __expf(b1)};
    __syncthreads();
}

constexpr int N_PHASES = 32;
__global__ void __launch_bounds__(NWAVES * 64, 2) fwd_kernel(Args args_byval) {
    (void)args_byval; const Args& args = *(const Args*)__builtin_amdgcn_kernarg_segment_ptr();
    extern __shared__ __attribute__((aligned(16))) unsigned char lds_raw[];
    LAS unsigned char* lds = (LAS unsigned char*)lds_raw;
    volatile LAS unsigned* MISC = (volatile LAS unsigned*)(lds + MISC_OFF);
    const int tid = threadIdx.x, lane = tid & 63, wave = __builtin_amdgcn_readfirstlane(tid >> 6);
    const int G = gridDim.x; const int bx = blockIdx.x; const int vcu = (G % 8 == 0) ? (bx % 8) * (G / 8) + bx / 8 : bx;
    unsigned char* ws = args.ws;
    gu32* ctl = (gu32*)(ws + WS_CTL);
    for (int u = tid; u < (LDS_BYTES - LDSCTL_OFF) / 4; u += NWAVES * 64) ((LAS unsigned*)(lds + LDSCTL_OFF))[u] = 0u;
    __syncthreads();
    XcdBarrier bar; bar.bar = (unsigned*)(ctl + CW_BAR); bar.x = 0; bar.st = nullptr;
    if (MK_ONE_LAUNCH) bar = xcd_barrier_post((unsigned*)(ctl + CW_BAR), MISC + 8);
    const int lo = args.ph_lo, hi = args.ph_hi;
    const bool late_w = MK_ONE_LAUNCH && G == 256 && lo == 0 && hi == N_PHASES;
    int ph = 0;
#define PHASE_BEGIN if (lo <= ph && ph < hi) { int tl_ = threadIdx.x; asm volatile("" : "+v"(tl_)); const int tid = tl_, lane = tl_ & 63; (void)tid; (void)lane;
#define PHASE_END   if (MK_ONE_LAUNCH && ph + 1 < hi) xcd_barrier(bar); } ++ph;
#define LATE_CONVERT() if (late_w && bx >= 128) { \
        transposes_masked(args, lds, lane, wave, LATE_JOBS, (bx - 128) * NWAVES + wave, 128 * NWAVES); \
        asm volatile("s_waitcnt vmcnt(0)" ::: "memory"); __syncthreads(); \
        if (tid == 0) { __builtin_amdgcn_fence(__ATOMIC_RELEASE, "agent"); asm volatile("s_waitcnt vmcnt(0)" ::: "memory"); (void)xb_add((unsigned*)(ctl + CW_BAR) + XB_LATE, 1u); } }
#define LATE_WAIT() if (late_w) { if (tid == 0) { unsigned* lb_ = (unsigned*)(ctl + CW_BAR); XB_SPIN(xb_ld(lb_ + XB_LATE) < 128u, lb_); \
        __builtin_amdgcn_fence(__ATOMIC_ACQUIRE, "agent"); asm volatile("s_waitcnt vmcnt(0)" ::: "memory"); } __syncthreads(); }
#define PHASE_END_GRID(glob) if (MK_ONE_LAUNCH && ph + 1 < hi) xcd_barrier(bar, glob); } ++ph;

    const float* x_in = (const float*)args.in[0];
    bf16* X = (bf16*)(ws + WS_X);
    bf16* Hb = (bf16*)(ws + WS_H);
    const float* mod = (const float*)(ws + WS_MOD);
    const float* n1g = (const float*)args.in[5]; const float* n2g = (const float*)args.in[6];
    bf16* FH = (bf16*)(ws + A_FH);

    PHASE_BEGIN prologue_phase(args, lds, tid, lane, wave, vcu, G, late_w); PHASE_END
    if (MK_ONE_LAUNCH && lo == 0 && hi > 1 && wave == 0) {
        unsigned* xt = (unsigned*)(ctl + CW_BAR) + XB_XTAB;
        bool ok = (G == 256);
#pragma unroll
        for (int k = 0; k < 4; ++k) { const int e = lane + 64 * k; if (e < G) ok = ok && (xb_ld(xt + e) == xb_ld(xt + (e & 7))); }
        const bool all = __builtin_amdgcn_ballot_w64(ok) == ~0ull;
        if (tid == 0) MISC[8 + 2] = all ? 1u : 0u;
    }

#define MODP(l, idx) (mod + (size_t)(l) * 8 * MODW + (size_t)(idx) * D)
#define NORM1(l, xsrc, ZP, XF) PHASE_BEGIN norm_phase<ZP, XF>(lds, xsrc, n1g + (l) * D, MODP(l, 0), MODP(l, 1), Hb, (const float*)(ws + WS_WZT), (float*)(ws + WS_Z), lane, wave, vcu, G); PHASE_END
#define FFN(l) \
    PHASE_BEGIN if constexpr ((FP8_FFN_MASK >> (l)) & 1) norm_phase<false, false, true>(lds, X, n2g + (l) * D, MODP(l, 3), MODP(l, 4), Hb, nullptr, nullptr, lane, wave, vcu, G); \
                else norm_phase<false, false, false>(lds, X, n2g + (l) * D, MODP(l, 3), MODP(l, 4), Hb, nullptr, nullptr, lane, wave, vcu, G); PHASE_END \
    PHASE_BEGIN { if ((l) == 2) { LATE_WAIT() } } if constexpr ((FP8_FFN_MASK >> (l)) & 1) { pg8::Gemm g{Hb, (const bf16*)(ws + WS_W_FFN_IN) + (size_t)(l) * FF2 * D, M, FF2, D / 2, D / 2, D / 2, 0}; pg8::StaticOrder S; S.init(M, FF2, G, bx); \
            pg8::EpiSwigluS E{FH, FF, 1.0f / (FP8_ASCALE * FP8_WSCALE)}; pg8::gemm_phase<pg8::EpiSwigluS, pg8::StaticOrder, true, true, false, false, true>(lds, g, S, E); } \
        else { pg8::Gemm g{Hb, (const bf16*)(ws + WS_W_FFN_IN) + (size_t)(l) * FF2 * D, M, FF2, D, D, D, 0}; pg8::StaticOrder S; S.init(M, FF2, G, bx); \
            pg8::EpiSwiglu E{FH, FF, 1.0f}; pg8::gemm_phase<pg8::EpiSwiglu, pg8::StaticOrder>(lds, g, S, E); } PHASE_END \
    PHASE_BEGIN { pg8::Gemm g{FH, (const bf16*)(ws + WS_W_FFN_OUT) + (size_t)(l) * D * FF, M, D, FF, FF, FF, 0}; pg8::StaticOrder S; S.init(M, D, G, bx); \
        pg8::EpiRes<false> E{X, X, MODP(l, 5), nullptr}; pg8::gemm_phase<pg8::EpiRes<false>, pg8::StaticOrder>(lds, g, S, E); } PHASE_END_GRID((l) < DEPTH - 1)

    NORM1(0, x_in, false, true)
    PHASE_BEGIN { pg8::Gemm g{Hb, (const bf16*)(ws + WS_W_RET_IN), M, RET_IN, D, D, D, 0}; pg8::StaticOrder S; S.init(M, RET_IN, G, bx);
        pg8::EpiRetIn E{(bf16*)(ws + A_RQ), (bf16*)(ws + A_RK), (bf16*)(ws + A_RV), (bf16*)(ws + A_RG), (const float*)(ws + WS_COS), (const float*)(ws + WS_SIN)};
        pg8::gemm_phase<pg8::EpiRetIn, pg8::StaticOrder>(lds, g, S, E); } PHASE_END
#define RET_SCAN PHASE_BEGIN for (int item = bx; item < 256; item += G) { const int pr = 8 * (item & 7) + (item >> 5), dvs_ = (item >> 3) & 3, hh = pr & 7;     \
        const float l2g = log1pf(-exp2f(-5.0f - (float)hh)) * 1.4426950408889634f; \
        scan_item2<false>(lds, (const bf16*)(ws + A_RQ), (const bf16*)(ws + A_RK), (const bf16*)(ws + A_RV), (bf16*)(ws + A_RO), nullptr, 2048, 4096, pr >> 3, hh, dvs_, exp2f(64.0f * l2g), tid); } PHASE_END
    RET_SCAN
    PHASE_BEGIN post_phase((bf16*)(ws + A_RO), (const bf16*)(ws + A_RG), RET_H, lane, wave, vcu, G); PHASE_END
    PHASE_BEGIN { pg8::Gemm g{(const bf16*)(ws + A_RO), (const bf16*)(ws + WS_W_RET_OUT), M, D, RET_VW, RET_VW, RET_VW, 0}; pg8::StaticOrder S; S.init(M, D, G, bx);
        pg8::EpiRes<true> E{x_in, X, MODP(0, 2), nullptr}; pg8::gemm_phase<pg8::EpiRes<true>, pg8::StaticOrder>(lds, g, S, E); } PHASE_END
    FFN(0)
    NORM1(1, X, false, false)
    PHASE_BEGIN { pg8::Gemm g{Hb, (const bf16*)(ws + WS_W_CONV_IN), M, CONV_INW, D, D, D, 0}; pg8::StaticOrder S; S.init(M, CONV_INW, G, bx);
        pg8::EpiConvIn E{(bf16*)(ws + A_CB), (bf16*)(ws + A_CCU)}; pg8::gemm_phase<pg8::EpiConvIn, pg8::StaticOrder>(lds, g, S, E); } PHASE_END
    PHASE_BEGIN conv_phase((const bf16*)(ws + A_CB), (const bf16*)(ws + A_CCU), (bf16*)(ws + A_CY), (const float*)args.in[10], tid, vcu, G); PHASE_END
    PHASE_BEGIN { pg8::Gemm g{(const bf16*)(ws + A_CY), (const bf16*)(ws + WS_W_CONV_OUT), M, D, D, D, D, 0}; pg8::StaticOrder S; S.init(M, D, G, bx);
        pg8::EpiRes<false> E{X, X, MODP(1, 2), nullptr}; pg8::gemm_phase<pg8::EpiRes<false>, pg8::StaticOrder>(lds, g, S, E); } PHASE_END
    FFN(1)
    NORM1(2, X, true, false)
    PHASE_BEGIN { pg8::Gemm g{Hb, (const bf16*)(ws + WS_W_GLA_IN), M, GLA_MAIN, D, D, D, 0}; pg8::StaticOrder S; S.init(M, GLA_MAIN, G, bx);
        pg8::EpiGlaIn E{(bf16*)(ws + A_GQ), (bf16*)(ws + A_GK), (bf16*)(ws + A_GV), (bf16*)(ws + A_GG)}; pg8::gemm_phase<pg8::EpiGlaIn, pg8::StaticOrder>(lds, g, S, E); } PHASE_END
    PHASE_BEGIN for (int item = bx; item < 256; item += G) gla_prep_item(lds, (bf16*)(ws + A_GQ), (bf16*)(ws + A_GK), (const float*)(ws + WS_Z), (const float*)args.in[13], (const float*)args.in[14], (float*)(ws + A_GE), 32 * (item & 7) + (item >> 3), tid); PHASE_END
#define GLA_SCAN PHASE_BEGIN LATE_CONVERT() for (int item = bx; item < 128; item += G) { const int pr = 4 * (item & 7) + (item >> 5), dvs_ = (item >> 3) & 3;     \
        scan_item2<true>(lds, (const bf16*)(ws + A_GQ), (const bf16*)(ws + A_GK), (const bf16*)(ws + A_GV), (bf16*)(ws + A_GO), (const float*)(ws + A_GE), \
        1024, 2048, pr >> 2, pr & 3, dvs_, 1.0f, tid); } PHASE_END
    GLA_SCAN
    PHASE_BEGIN post_phase((bf16*)(ws + A_GO), (const bf16*)(ws + A_GG), GLA_H, lane, wave, vcu, G); PHASE_END
    PHASE_BEGIN { pg8::Gemm g{(const bf16*)(ws + A_GO), (const bf16*)(ws + WS_W_GLA_OUT), M, D, D, D, D, 0}; pg8::StaticOrder S; S.init(M, D, G, bx);
        pg8::EpiRes<false> E{X, X, MODP(2, 2), nullptr}; pg8::gemm_phase<pg8::EpiRes<false>, pg8::StaticOrder>(lds, g, S, E); } PHASE_END
    FFN(2)
    NORM1(3, X, false, false)
    PHASE_BEGIN pool_phase(Hb, (bf16*)(ws + A_PM), tid, vcu, G); PHASE_END
    PHASE_BEGIN { pg8::Gemm g{(const bf16*)(ws + A_PM), (const bf16*)(ws + WS_W_POOL), M, D, 512, D, 512, 512}; pg8::StaticOrder S; S.init(M, D, G, bx);
        pg8::EpiRes<false> E{X, X, MODP(3, 2), (const float*)args.in[17]}; pg8::gemm_phase<pg8::EpiRes<false>, pg8::StaticOrder>(lds, g, S, E); } PHASE_END
    FFN(3)
    PHASE_BEGIN final_norm_phase(X, (const float*)args.in[20], args.out, lane, wave, vcu, G); PHASE_END
#undef PHASE_BEGIN
#undef PHASE_END
#undef PHASE_END_GRID
#undef LATE_CONVERT
#undef LATE_WAIT
}

extern "C" void kernel_launch(void* const* d_in, const int* in_sizes, int n_in, void* d_out, int out_size, void* d_ws, size_t ws_size, hipStream_t stream) {
    static int grid = 0;
    if (grid == 0) {
        if (n_in != 21 || in_sizes[0] != M * D || out_size != M * D || ws_size < WS_END) { fprintf(stderr, "kernel_launch: unexpected shapes (n_in %d, in0 %d, out %d, ws %zu, need %zu); nothing launched\n", n_in, n_in > 0 ? in_sizes[0] : -1, out_size, ws_size, (size_t)WS_END); grid = -1; return; }
        int dev = 0, cus = 0, per_cu = 0;
        if (hipGetDevice(&dev) != hipSuccess || hipDeviceGetAttribute(&cus, hipDeviceAttributeMultiprocessorCount, dev) != hipSuccess) { grid = -1; return; }
        if (hipFuncSetAttribute((const void*)fwd_kernel, hipFuncAttributeMaxDynamicSharedMemorySize, LDS_BYTES) != hipSuccess) { fprintf(stderr, "kernel_launch: hipFuncSetAttribute failed\n"); grid = -1; return; }
        if (hipOccupancyMaxActiveBlocksPerMultiprocessor(&per_cu, (const void*)fwd_kernel, NWAVES * 64, LDS_BYTES) != hipSuccess || per_cu < 1)
            fprintf(stderr, "kernel_launch: note: occupancy query reports %d workgroups per CU\n", per_cu);
        (void)hipGetLastError();
        grid = cus;
    }
    if (grid < 0) return;
    if (hipMemsetAsync((char*)d_ws + WS_CTL, 0, CTL_ZERO_BYTES, stream) != hipSuccess) { fprintf(stderr, "kernel_launch: memset failed\n"); return; }
    Args a{};
    for (int i = 0; i < 21; ++i) a.in[i] = d_in[i];
    a.out = (float*)d_out; a.ws = (unsigned char*)d_ws;
#if MK_ONE_LAUNCH
    a.ph_lo = 0; a.ph_hi = N_PHASES;
    hipLaunchKernelGGL(fwd_kernel, dim3(grid), dim3(NWAVES * 64), LDS_BYTES, stream, a);
#else
    for (int p = 0; p < N_PHASES; ++p) { a.ph_lo = p; a.ph_hi = p + 1; hipLaunchKernelGGL(fwd_kernel, dim3(grid), dim3(NWAVES * 64), LDS_BYTES, stream, a); }
#endif
    const hipError_t le = hipPeekAtLastError();
    if (le != hipSuccess) fprintf(stderr, "kernel_launch: launch failed: %s\n", hipGetErrorName(le));
}
```

```cpp
#include <hip/hip_runtime.h>
#include <cstdio>
#include <cstdint>

#ifndef FP8_FFN_MASK
#define FP8_FFN_MASK 0x0
#endif
#ifndef MK_ONE_LAUNCH
#define MK_ONE_LAUNCH 1
#endif

namespace pg8 {
#define PG8_LAS __attribute__((address_space(3)))
typedef unsigned short bf16_t;
typedef short bf16x8 __attribute__((ext_vector_type(8)));
typedef float f32x4 __attribute__((ext_vector_type(4)));
typedef unsigned u32x4 __attribute__((ext_vector_type(4)));
constexpr int BM = 256, BK = 64, HALF = 128, HTB = HALF * BK * 2, STAGE_BYTES = 8 * HTB, NXCD = 8, WGM = 8;

__host__ __device__ __forceinline__ int lds_byte(int r, int c) { const int st = (r >> 4) * 2 + (c >> 5), rr = r & 15, cc = c & 31, ob = rr * 64 + cc * 2; return st * 1024 + (ob ^ (((ob >> 9) & 1) << 5)); }
__host__ __device__ __forceinline__ void stage_rc(int b, int& R, int& C) { const int st = b / 1024, sb = b % 1024, swz = sb ^ (((sb >> 9) & 1) << 5); R = (st >> 1) * 16 + swz / 64; C = (st & 1) * 32 + (swz % 64) / 2; }
__host__ __device__ __forceinline__ int perm32(int rho) { const int n = rho >> 4, i = rho & 15; return 8 * (i >> 2) + 4 * n + (i & 3); }

struct Unit { int pm, pn; };
struct Gemm { const bf16_t* A; const bf16_t* Bt; int M, N, K, lda, ldb, grp; };

struct StaticOrder {
    int nM, nN, nwg, G, c;
    __host__ __device__ void init(int M, int N, int G_, int c_) { nM = M / BM; nN = N / BM; nwg = nM * nN; G = G_; c = c_; }
    __host__ __device__ bool next(int i, Unit& u) const {
        const long L = (long)i * G + c; if (L >= nwg) return false;
        int wgid = (int)L; { const int q = nwg / NXCD, r = nwg % NXCD, xcd = wgid % NXCD, off = wgid / NXCD; wgid = (xcd < r ? xcd * (q + 1) : r * (q + 1) + (xcd - r) * q) + off; }
        const int nig = WGM * nN, gid = wgid / nig, fm = gid * WGM, gsz = (nM - fm) < WGM ? (nM - fm) : WGM;
        u.pm = fm + ((wgid % nig) % gsz); u.pn = (wgid % nig) / gsz; return true;
    }
    __device__ __forceinline__ void a_ready(const Unit&) const {}
    __device__ __forceinline__ void done(const Unit&) const {}
};

__device__ __forceinline__ unsigned cvt_pk_bf16(float lo, float hi) { unsigned r; asm volatile("v_cvt_pk_bf16_f32 %0, %1, %2" : "=v"(r) : "v"(lo), "v"(hi)); return r; }
typedef int v8i_t __attribute__((ext_vector_type(8)));
typedef int v4i_t __attribute__((ext_vector_type(4)));
__device__ __forceinline__ float silu_f(float x) { return x * __builtin_amdgcn_rcpf(1.0f + __expf(-x)); }
__device__ __forceinline__ u32x4 pack8(const f32x4& a, const f32x4& b) { u32x4 w; w.x = cvt_pk_bf16(a[0], a[1]); w.y = cvt_pk_bf16(a[2], a[3]); w.z = cvt_pk_bf16(b[0], b[1]); w.w = cvt_pk_bf16(b[2], b[3]); return w; }


template <bool SCALED>
struct EpiSwigluT {
    static constexpr bool PERM = true, AFTER_DRAIN = false; static constexpr int NST = 8;
    bf16_t* O; int ldc; float sc;
    __device__ __forceinline__ void operator()(const f32x4 (&acc)[2][2][4][2], const Unit& u, int wr, int wc, int fr, int fq) const {
        const int row0 = u.pm * BM + wr * 64 + fr, col0 = u.pn * HALF + wc * 32 + 8 * fq;
#pragma unroll
        for (int ai = 0; ai < 2; ++ai)
#pragma unroll
            for (int m = 0; m < 4; ++m) { bf16_t* rowp = O + (size_t)(row0 + ai * HALF + m * 16) * ldc + col0;
                f32x4 v0, v1;
#pragma unroll
                for (int e = 0; e < 4; ++e) { if constexpr (SCALED) { v0[e] = silu_f(acc[ai][0][m][0][e] * sc) * (acc[ai][1][m][0][e] * sc); v1[e] = silu_f(acc[ai][0][m][1][e] * sc) * (acc[ai][1][m][1][e] * sc); }
                    else { v0[e] = silu_f(acc[ai][0][m][0][e]) * acc[ai][1][m][0][e]; v1[e] = silu_f(acc[ai][0][m][1][e]) * acc[ai][1][m][1][e]; } }
                *(u32x4*)rowp = pack8(v0, v1); }
    }
};
typedef EpiSwigluT<false> EpiSwiglu;
typedef EpiSwigluT<true> EpiSwigluS;
struct EpiRetIn {
    static constexpr bool PERM = true, AFTER_DRAIN = false; static constexpr int NST = 16;
    bf16_t *Q, *Kb, *V, *G; const float *cosT, *sinT;
    __device__ __forceinline__ void operator()(const f32x4 (&acc)[2][2][4][2], const Unit& u, int wr, int wc, int fr, int fq) const {
        const int row0 = u.pm * BM + wr * 64 + fr, cl = wc * 32 + 8 * fq;
        if (u.pn < 16) {
            const bool isk = u.pn >= 8; const int head = u.pn & 7; bf16_t* base = isk ? Kb : Q;
            const float l2g = log1pf(-exp2f(-5.0f - (float)head)) * 1.4426950408889634f;
#pragma unroll
            for (int ai = 0; ai < 2; ++ai)
#pragma unroll
                for (int m = 0; m < 4; ++m) { const int row = row0 + ai * HALF + m * 16;
                    const float tcp = (float)((row & 63) + 1);
                    const float sc = isk ? 0.0625f * exp2f(-tcp * l2g) : exp2f(tcp * l2g);
                    const f32x4 c0 = *(const f32x4*)(cosT + (size_t)row * 128 + cl), c1 = *(const f32x4*)(cosT + (size_t)row * 128 + cl + 4);
                    const f32x4 s0 = *(const f32x4*)(sinT + (size_t)row * 128 + cl), s1 = *(const f32x4*)(sinT + (size_t)row * 128 + cl + 4);
                    const f32x4 a0 = acc[ai][0][m][0], a1 = acc[ai][0][m][1], b0 = acc[ai][1][m][0], b1 = acc[ai][1][m][1];
                    const f32x4 o10 = (a0 * c0 - b0 * s0) * sc, o11 = (a1 * c1 - b1 * s1) * sc, o20 = (b0 * c0 + a0 * s0) * sc, o21 = (b1 * c1 + a1 * s1) * sc;
                    bf16_t* rowp = base + (size_t)row * 2048 + head * 256 + cl;
                    *(u32x4*)rowp = pack8(o10, o11); *(u32x4*)(rowp + HALF) = pack8(o20, o21); }
        } else {
            const bool isg = u.pn >= 32; bf16_t* base = (isg ? G : V) + ((u.pn - (isg ? 32 : 16)) * 256 + cl);
#pragma unroll
            for (int ai = 0; ai < 2; ++ai)
#pragma unroll
                for (int m = 0; m < 4; ++m) { bf16_t* rowp = base + (size_t)(row0 + ai * HALF + m * 16) * 4096;
#pragma unroll
                    for (int bj = 0; bj < 2; ++bj) { f32x4 v0 = acc[ai][bj][m][0], v1 = acc[ai][bj][m][1];
                        if (isg) {
#pragma unroll
                            for (int e = 0; e < 4; ++e) { v0[e] = silu_f(v0[e]); v1[e] = silu_f(v1[e]); } }
                        *(u32x4*)(rowp + bj * HALF) = pack8(v0, v1); } }
        }
    }
};
struct EpiConvIn {
    static constexpr bool PERM = true, AFTER_DRAIN = false; static constexpr int NST = 8;
    bf16_t *Bg, *CU;
    __device__ __forceinline__ void operator()(const f32x4 (&acc)[2][2][4][2], const Unit& u, int wr, int wc, int fr, int fq) const {
        const int row0 = u.pm * BM + wr * 64 + fr, cl = wc * 32 + 8 * fq;
        if (u.pn < 8) {
#pragma unroll
            for (int ai = 0; ai < 2; ++ai)
#pragma unroll
                for (int m = 0; m < 4; ++m) { bf16_t* rowp = Bg + (size_t)(row0 + ai * HALF + m * 16) * 2048 + u.pn * 256 + cl;
#pragma unroll
                    for (int bj = 0; bj < 2; ++bj) *(u32x4*)(rowp + bj * HALF) = pack8(acc[ai][bj][m][0], acc[ai][bj][m][1]); }
        } else {
#pragma unroll
            for (int ai = 0; ai < 2; ++ai)
#pragma unroll
                for (int m = 0; m < 4; ++m) { bf16_t* rowp = CU + (size_t)(row0 + ai * HALF + m * 16) * 2048 + (u.pn - 8) * HALF + cl;
                    *(u32x4*)rowp = pack8(acc[ai][0][m][0] * acc[ai][1][m][0], acc[ai][0][m][1] * acc[ai][1][m][1]); }
        }
    }
};
struct EpiGlaIn {
    static constexpr bool PERM = true, AFTER_DRAIN = false; static constexpr int NST = 16;
    bf16_t *Q, *Kb, *V, *G;
    __device__ __forceinline__ void operator()(const f32x4 (&acc)[2][2][4][2], const Unit& u, int wr, int wc, int fr, int fq) const {
        const int row0 = u.pm * BM + wr * 64 + fr, cl = wc * 32 + 8 * fq;
        bf16_t* base; int ld; float sc = 1.f; const bool isg = u.pn >= 16;
        if (u.pn < 4) { base = Q + u.pn * 256; ld = 1024; sc = 0.0625f; } else if (u.pn < 8) { base = Kb + (u.pn - 4) * 256; ld = 1024; }
        else if (u.pn < 16) { base = V + (u.pn - 8) * 256; ld = 2048; } else { base = G + (u.pn - 16) * 256; ld = 2048; }
#pragma unroll
        for (int ai = 0; ai < 2; ++ai)
#pragma unroll
            for (int m = 0; m < 4; ++m) { bf16_t* rowp = base + (size_t)(row0 + ai * HALF + m * 16) * ld + cl;
#pragma unroll
                for (int bj = 0; bj < 2; ++bj) { f32x4 v0 = acc[ai][bj][m][0] * sc, v1 = acc[ai][bj][m][1] * sc;
                    if (isg) {
#pragma unroll
                        for (int e = 0; e < 4; ++e) { v0[e] = silu_f(v0[e]); v1[e] = silu_f(v1[e]); } }
                    *(u32x4*)(rowp + bj * HALF) = pack8(v0, v1); } }
    }
};
struct EpiNull {
    static constexpr bool PERM = true, AFTER_DRAIN = false; static constexpr int NST = 0;
    bf16_t* O;
    __device__ __forceinline__ void operator()(const f32x4 (&acc)[2][2][4][2], const Unit& u, int wr, int wc, int fr, int fq) const {
        float s = 0.f;
#pragma unroll
        for (int ai = 0; ai < 2; ++ai)
#pragma unroll
            for (int bj = 0; bj < 2; ++bj)
#pragma unroll
                for (int m = 0; m < 4; ++m)
#pragma unroll
                    for (int n = 0; n < 2; ++n) s += acc[ai][bj][m][n][0] + acc[ai][bj][m][n][1] + acc[ai][bj][m][n][2] + acc[ai][bj][m][n][3];
        if (s == 1.2345e30f) O[u.pm + fr] = 0;
    }
};
template <bool XIN_F32>
struct EpiRes {
    static constexpr bool PERM = true, AFTER_DRAIN = false; static constexpr int NST = 16;
    const void* xin; bf16_t* xout; const float* gate; const float* cscale;
    __device__ __forceinline__ void operator()(const f32x4 (&acc)[2][2][4][2], const Unit& u, int wr, int wc, int fr, int fq) const {
        const int row0 = u.pm * BM + wr * 64 + fr, col0 = u.pn * BM + wc * 32 + 8 * fq;
        const float* gp = gate + (size_t)(u.pm >> 3) * 12288 + col0;
        f32x4 gv[2][2];
#pragma unroll
        for (int bj = 0; bj < 2; ++bj)
#pragma unroll
            for (int n = 0; n < 2; ++n) { gv[bj][n] = *(const f32x4*)(gp + bj * HALF + n * 4); if (cscale) gv[bj][n] = gv[bj][n] * *(const f32x4*)(cscale + col0 + bj * HALF + n * 4); }
        if constexpr (XIN_F32) {
#pragma unroll
            for (int ai = 0; ai < 2; ++ai)
#pragma unroll
                for (int mh = 0; mh < 2; ++mh) { f32x4 xv[2][2][2];
#pragma unroll
                    for (int m2 = 0; m2 < 2; ++m2)
#pragma unroll
                        for (int bj = 0; bj < 2; ++bj) { const float* p = (const float*)xin + (size_t)(row0 + ai * HALF + (2 * mh + m2) * 16) * 2048 + col0 + bj * HALF; xv[m2][bj][0] = *(const f32x4*)p; xv[m2][bj][1] = *(const f32x4*)(p + 4); }
#pragma unroll
                    for (int m2 = 0; m2 < 2; ++m2)
#pragma unroll
                        for (int bj = 0; bj < 2; ++bj) { const int m = 2 * mh + m2;
                            *(u32x4*)(xout + (size_t)(row0 + ai * HALF + m * 16) * 2048 + col0 + bj * HALF) = pack8(xv[m2][bj][0] + gv[bj][0] * acc[ai][bj][m][0], xv[m2][bj][1] + gv[bj][1] * acc[ai][bj][m][1]); }
                    asm volatile("" ::: "memory"); }
        } else {
#pragma unroll
            for (int ai = 0; ai < 2; ++ai) { u32x4 xw[4][2];
#pragma unroll
                for (int m = 0; m < 4; ++m)
#pragma unroll
                    for (int bj = 0; bj < 2; ++bj) xw[m][bj] = *(const u32x4*)((const bf16_t*)xin + (size_t)(row0 + ai * HALF + m * 16) * 2048 + col0 + bj * HALF);
#pragma unroll
                for (int m = 0; m < 4; ++m)
#pragma unroll
                    for (int bj = 0; bj < 2; ++bj) { const u32x4 w = xw[m][bj];
                        const f32x4 x0 = (f32x4){__builtin_bit_cast(float, w.x << 16), __builtin_bit_cast(float, w.x & 0xffff0000u), __builtin_bit_cast(float, w.y << 16), __builtin_bit_cast(float, w.y & 0xffff0000u)};
                        const f32x4 x1 = (f32x4){__builtin_bit_cast(float, w.z << 16), __builtin_bit_cast(float, w.z & 0xffff0000u), __builtin_bit_cast(float, w.w << 16), __builtin_bit_cast(float, w.w & 0xffff0000u)};
                        *(u32x4*)(xout + (size_t)(row0 + ai * HALF + m * 16) * 2048 + col0 + bj * HALF) = pack8(x0 + gv[bj][0] * acc[ai][bj][m][0], x1 + gv[bj][1] * acc[ai][bj][m][1]); }
                asm volatile("" ::: "memory"); }
        }
    }
};

template <class Epi, class Sched, bool ALIGN_EPI = true, bool SP2 = true, bool FULLLINE = false, bool NOSTAGE = false, bool FP8 = false>
__device__ __forceinline__ void gemm_phase(PG8_LAS unsigned char* lds, const Gemm g, const Sched& S, const Epi& E) {
    const int tid = threadIdx.x, wid = __builtin_amdgcn_readfirstlane(tid >> 6), lane = tid & 63, wr = wid >> 2, wc = wid & 3, fr = lane & 15, fq = lane >> 4;
    const int K = g.K, nt = K / BK;
    unsigned voffA_, voffB_;
    { int R, C; stage_rc(tid * 16, R, C); const int Rb = Epi::PERM ? ((R & ~31) + perm32(R & 31)) : R;
      voffA_ = (unsigned)(R * g.lda + C) * 2u; voffB_ = (unsigned)(Rb * g.ldb + C) * 2u; }
    const unsigned voffA = voffA_, voffB = voffB_;
    const size_t pstepoffA = (size_t)64 * g.lda * 2, pstepoffB = (size_t)64 * g.ldb * 2;
    const size_t kstep = (size_t)(BK * 2);
    const size_t hstepA = (size_t)HALF * g.lda * 2, hstepB = (size_t)HALF * g.ldb * 2;
    const size_t tstepA = 2 * hstepA, tstepB = 2 * hstepB;
    const unsigned ldsw = (unsigned)wid * 1024u;
    const int aoff = lds_byte(wr * 64 + fr, fq * 8), boff = lds_byte(wc * 32 + fr, fq * 8);
#define PG8_SA(b, h) (((b) * 2 + (h)) * HTB)
#define PG8_SB(b, h) ((4 + (b) * 2 + (h)) * HTB)
#define PG8_STAGE(bufoff, gbase, voff) do { if constexpr (!NOSTAGE) _Pragma("unroll") for (int _i = 0; _i < 2; ++_i) \
        __builtin_amdgcn_global_load_lds((const unsigned*)((const char*)(gbase) + (size_t)_i * pstep##voff + v##voff), (PG8_LAS unsigned*)(lds + (bufoff) + ldsw + _i * 8192), 16, 0, 0); } while (0)
#define PG8_LDA(dst, b, h) do { _Pragma("unroll") for (int m = 0; m < 4; ++m) { const v4i_t l0_ = *(const PG8_LAS v4i_t*)(lds + PG8_SA(b, h) + aoff + m * 2048), l1_ = *(const PG8_LAS v4i_t*)(lds + PG8_SA(b, h) + aoff + m * 2048 + 1024); \
        dst[m] = __builtin_shufflevector(l0_, l1_, 0, 1, 2, 3, 4, 5, 6, 7); } } while (0)
#define PG8_LDB(dst, b, h) do { _Pragma("unroll") for (int n = 0; n < 2; ++n) { const v4i_t l0_ = *(const PG8_LAS v4i_t*)(lds + PG8_SB(b, h) + boff + n * 2048), l1_ = *(const PG8_LAS v4i_t*)(lds + PG8_SB(b, h) + boff + n * 2048 + 1024); \
        dst[n] = __builtin_shufflevector(l0_, l1_, 0, 1, 2, 3, 4, 5, 6, 7); } } while (0)
#define PG8_MMA(ai, bj, At, Bt) do { __builtin_amdgcn_s_setprio(1); _Pragma("unroll") for (int m = 0; m < 4; ++m) _Pragma("unroll") for (int n = 0; n < 2; ++n) { \
        if constexpr (FP8) acc[ai][bj][m][n] = __builtin_amdgcn_mfma_scale_f32_16x16x128_f8f6f4(Bt[n], At[m], acc[ai][bj][m][n], 0, 0, 0, 0x7f7f7f7f, 0, 0x7f7f7f7f); \
        else { const v4i_t a0_ = __builtin_shufflevector(At[m], At[m], 0, 1, 2, 3), a1_ = __builtin_shufflevector(At[m], At[m], 4, 5, 6, 7), b0_ = __builtin_shufflevector(Bt[n], Bt[n], 0, 1, 2, 3), b1_ = __builtin_shufflevector(Bt[n], Bt[n], 4, 5, 6, 7); \
            acc[ai][bj][m][n] = __builtin_amdgcn_mfma_f32_16x16x32_bf16(__builtin_bit_cast(bf16x8, b0_), __builtin_bit_cast(bf16x8, a0_), acc[ai][bj][m][n], 0, 0, 0); \
            acc[ai][bj][m][n] = __builtin_amdgcn_mfma_f32_16x16x32_bf16(__builtin_bit_cast(bf16x8, b1_), __builtin_bit_cast(bf16x8, a1_), acc[ai][bj][m][n], 0, 0, 0); } } __builtin_amdgcn_s_setprio(0); } while (0)
#define PG8_WAIT_V(n) asm volatile("s_waitcnt vmcnt(" #n ")" ::: "memory")
#define PG8_WAIT_L(n) asm volatile("s_waitcnt lgkmcnt(" #n ")" ::: "memory")
#define PG8_BAR __builtin_amdgcn_s_barrier()
#define PG8_SCHED __builtin_amdgcn_sched_barrier(0)
#define PG8_ABASE(u) ((const char*)g.A + (size_t)(u).pm * tstepA + (g.grp ? (size_t)(((u).pn * BM) / g.grp) * (size_t)g.grp * 2 : (size_t)0))
#define PG8_BBASE(u) ((const char*)g.Bt + (size_t)(u).pn * tstepB)
    Unit cur, nxt; int ui = 0;
    if (!S.next(0, cur)) return;
    f32x4 acc[2][2][4][2];
#pragma unroll
    for (int a = 0; a < 2; ++a)
#pragma unroll
        for (int b = 0; b < 2; ++b)
#pragma unroll
            for (int m = 0; m < 4; ++m)
#pragma unroll
                for (int n = 0; n < 2; ++n) acc[a][b][m][n] = (f32x4){0.f, 0.f, 0.f, 0.f};
    v8i_t At[4], B0[2], B1[2];
    const char* cA = PG8_ABASE(cur); const char* cB = PG8_BBASE(cur);
    S.a_ready(cur);
    if constexpr (SP2) {
    PG8_STAGE(PG8_SB(0, 0), cB, offB); PG8_STAGE(PG8_SB(0, 1), cB + hstepB, offB); PG8_STAGE(PG8_SA(0, 0), cA, offA); PG8_STAGE(PG8_SA(0, 1), cA + hstepA, offA);
    if (wr == 1) PG8_BAR;
    PG8_WAIT_V(2); PG8_BAR;
    PG8_STAGE(PG8_SB(1, 0), cB + kstep, offB); PG8_STAGE(PG8_SA(1, 0), cA + kstep, offA); PG8_STAGE(PG8_SB(1, 1), cB + hstepB + kstep, offB);
    PG8_WAIT_V(0); PG8_BAR;
    } else {
    PG8_STAGE(PG8_SB(0, 0), cB, offB); PG8_STAGE(PG8_SA(0, 0), cA, offA); PG8_STAGE(PG8_SB(0, 1), cB + hstepB, offB); PG8_STAGE(PG8_SA(0, 1), cA + hstepA, offA);
    if (wr == 1) PG8_BAR;
    PG8_WAIT_V(4); PG8_BAR;
    PG8_STAGE(PG8_SB(1, 0), cB + kstep, offB); PG8_STAGE(PG8_SA(1, 0), cA + kstep, offA); PG8_STAGE(PG8_SB(1, 1), cB + hstepB + kstep, offB);
    PG8_WAIT_V(6); PG8_BAR;
    }
    for (;;) {
        const bool has_next = S.next(ui + 1, nxt);
        const char* nA = has_next ? PG8_ABASE(nxt) : cA; const char* nB = has_next ? PG8_BBASE(nxt) : cB;
#define PG8_ITER(WAITA) do { \
            const bool last = (t == nt - 2); \
            const char* a1 = cA + (size_t)(t + 1) * kstep; \
            const char* a2 = last ? nA : cA + (size_t)(t + 2) * kstep; const char* b2 = last ? nB : cB + (size_t)(t + 2) * kstep; \
            const char* a3 = a2 + kstep; const char* b3 = b2 + kstep; \
            if (last && has_next) S.a_ready(nxt); \
            PG8_LDB(B0, 0, 0); PG8_LDB(B1, 0, 1); PG8_SCHED; PG8_LDA(At, 0, 0); PG8_STAGE(PG8_SA(1, 1), a1 + hstepA, offA); \
            WAITA; PG8_WAIT_L(0); PG8_BAR; PG8_MMA(0, 0, At, B0); PG8_MMA(0, 1, At, B1); PG8_BAR; PG8_SCHED; \
            PG8_LDA(At, 0, 1); PG8_STAGE(PG8_SB(0, 0), b2, offB); PG8_STAGE(PG8_SB(0, 1), b2 + hstepB, offB); PG8_STAGE(PG8_SA(0, 0), a2, offA); \
            WAITA; PG8_WAIT_L(0); PG8_BAR; PG8_MMA(1, 0, At, B0); PG8_MMA(1, 1, At, B1); PG8_BAR; PG8_SCHED; \
            PG8_LDB(B0, 1, 0); PG8_LDB(B1, 1, 1); PG8_SCHED; PG8_LDA(At, 1, 0); PG8_STAGE(PG8_SA(0, 1), a2 + hstepA, offA); \
            PG8_WAIT_V(8); PG8_WAIT_L(0); PG8_BAR; PG8_MMA(0, 0, At, B0); PG8_MMA(0, 1, At, B1); PG8_BAR; PG8_SCHED; \
            PG8_LDA(At, 1, 1); PG8_STAGE(PG8_SB(1, 0), b3, offB); PG8_STAGE(PG8_SB(1, 1), b3 + hstepB, offB); PG8_STAGE(PG8_SA(1, 0), a3, offA); \
            PG8_WAIT_V(8); PG8_WAIT_L(0); PG8_BAR; PG8_MMA(1, 0, At, B0); PG8_MMA(1, 1, At, B1); PG8_BAR; PG8_SCHED; } while (0)
        static_assert(SP2, "only the SP2 loop is kept");
        { const int t = 0; if constexpr (Epi::NST == 16) PG8_ITER(PG8_WAIT_V(24)); else if constexpr (Epi::NST == 8) PG8_ITER(PG8_WAIT_V(16)); else PG8_ITER(PG8_WAIT_V(8)); }
        for (int t = 2; t < nt; t += 2) PG8_ITER(PG8_WAIT_V(8));
#undef PG8_ITER
        if constexpr (ALIGN_EPI) { if (wr == 0) PG8_BAR; }
        { int ln_ = lane; asm volatile("" : "+v"(ln_));
          E(acc, cur, wr, wc, ln_ & 15, ln_ >> 4); } S.done(cur);
        if (!has_next) break;
#pragma unroll
        for (int a = 0; a < 2; ++a)
#pragma unroll
            for (int b = 0; b < 2; ++b)
#pragma unroll
                for (int m = 0; m < 4; ++m)
#pragma unroll
                    for (int n = 0; n < 2; ++n) acc[a][b][m][n] = (f32x4){0.f, 0.f, 0.f, 0.f};
        cur = nxt; cA = nA; cB = nB; ++ui;
        if constexpr (ALIGN_EPI) { if (wr == 1) PG8_BAR; }
    }
    PG8_WAIT_V(0);
    if constexpr (!ALIGN_EPI) { if (wr == 0) PG8_BAR; }
    PG8_BAR;
#undef PG8_SA
#undef PG8_SB
#undef PG8_STAGE
#undef PG8_LDA
#undef PG8_LDB
#undef PG8_MMA
#undef PG8_WAIT_V
#undef PG8_WAIT_L
#undef PG8_BAR
#undef PG8_SCHED
#undef PG8_ABASE
#undef PG8_BBASE
}
}

constexpr int NWAVES = 8;
constexpr int BATCH = 8, SEQ = 2048, D = 2048, M = BATCH * SEQ, DEPTH = 4;
constexpr int FF = 5632, FF2 = 2 * FF;
constexpr int RET_H = 8, RET_IN = 12288, RET_VW = 4096;
constexpr int GLA_H = 4, GLA_QK = 1024, GLA_VW = 2048, GLA_INW = 6160, GLA_MAIN = 6144;
constexpr int CONV_INW = 6144;
constexpr float EPS = 1e-6f;
constexpr int MODW = 6 * D;

constexpr size_t MiB = 1u << 20;
constexpr size_t WS_CTL = 0, CTL_ZERO_BYTES = 1 * MiB;
constexpr size_t WS_MOD = 1 * MiB;
constexpr size_t WS_Z = 3 * MiB;
constexpr size_t WS_WZT = 4 * MiB;
constexpr size_t WS_COS = 5 * MiB, WS_SIN = 13 * MiB;
constexpr size_t WS_W_RET_IN = 21 * MiB;
constexpr size_t WS_W_RET_OUT = 69 * MiB;
constexpr size_t WS_W_CONV_IN = 85 * MiB;
constexpr size_t WS_W_CONV_OUT = 109 * MiB;
constexpr size_t WS_W_GLA_IN = 117 * MiB;
constexpr size_t WS_W_GLA_OUT = 141 * MiB;
constexpr size_t WS_W_POOL = 149 * MiB;
constexpr size_t WS_W_FFN_IN = 151 * MiB;
constexpr size_t WS_W_FFN_OUT = 327 * MiB;
constexpr size_t WS_X = 415 * MiB;
constexpr size_t WS_H = 479 * MiB;
constexpr size_t WS_ACT = 543 * MiB;
constexpr size_t WS_FH = WS_ACT + 512 * MiB;
constexpr size_t WS_END = WS_FH + 176 * MiB;
constexpr size_t A_RQ = WS_ACT, A_RK = WS_ACT + 64 * MiB, A_RV = WS_ACT + 128 * MiB, A_RG = WS_ACT + 256 * MiB, A_RO = WS_ACT + 384 * MiB;
constexpr size_t A_CB = WS_ACT, A_CCU = WS_ACT + 64 * MiB, A_CY = WS_ACT + 128 * MiB;
constexpr size_t A_GE = WS_ACT + 448 * MiB;
constexpr size_t A_GQ = WS_ACT, A_GK = WS_ACT + 32 * MiB, A_GV = WS_ACT + 64 * MiB, A_GG = WS_ACT + 128 * MiB, A_GO = WS_ACT + 192 * MiB;
constexpr size_t A_PM = WS_ACT;
constexpr size_t A_FH = WS_FH;
constexpr int CW_TMO = 0, CW_BAR = 4096;

constexpr int RING_BYTES = 131072;
constexpr int LDSCTL_OFF = RING_BYTES, MISC_OFF = LDSCTL_OFF + 320;
constexpr int LDS_BYTES = 147456;

#define GAS __attribute__((address_space(1)))
#define LAS __attribute__((address_space(3)))
typedef unsigned short bf16;
typedef unsigned v4u __attribute__((ext_vector_type(4)));
typedef unsigned v2u __attribute__((ext_vector_type(2)));
typedef float f32x4 __attribute__((ext_vector_type(4)));
typedef GAS unsigned gu32;
#define RLX_AGENT __ATOMIC_RELAXED, __HIP_MEMORY_SCOPE_AGENT
#define LDS_WAIT() asm volatile("s_waitcnt lgkmcnt(0)" ::: "memory")
__device__ __forceinline__ unsigned f2bf(float f) { unsigned u = __builtin_bit_cast(unsigned, f); return (u + 0x7fffu + ((u >> 16) & 1u)) >> 16; }
__device__ __forceinline__ unsigned pk2(float lo, float hi) { return f2bf(lo) | (f2bf(hi) << 16); }
__device__ __forceinline__ v2u pack8_fp8(float a0, float a1, float a2, float a3, float a4, float a5, float a6, float a7, float sc) {
    int lo = __builtin_amdgcn_cvt_pk_fp8_f32(a0 * sc, a1 * sc, 0, false); lo = __builtin_amdgcn_cvt_pk_fp8_f32(a2 * sc, a3 * sc, lo, true);
    int hi = __builtin_amdgcn_cvt_pk_fp8_f32(a4 * sc, a5 * sc, 0, false); hi = __builtin_amdgcn_cvt_pk_fp8_f32(a6 * sc, a7 * sc, hi, true);
    v2u r; r.x = (unsigned)lo; r.y = (unsigned)hi; return r;
}
constexpr float FP8_ASCALE = 4.0f, FP8_WSCALE = 64.0f;
__device__ __forceinline__ float bflo(unsigned w) { return __builtin_bit_cast(float, w << 16); }
__device__ __forceinline__ float bfhi(unsigned w) { return __builtin_bit_cast(float, w & 0xffff0000u); }

__device__ __forceinline__ void unpack8(const v4u& w, float (&f)[8]) { f[0] = bflo(w.x); f[1] = bfhi(w.x); f[2] = bflo(w.y); f[3] = bfhi(w.y); f[4] = bflo(w.z); f[5] = bfhi(w.z); f[6] = bflo(w.w); f[7] = bfhi(w.w); }
#define XB_TMO      128
#define XB_XCNT(j)  (256  + 64 * (j))
#define XB_XSUB(j)  (1280 + 64 * (j))
#define XB_XGEN(j)  (2304 + 64 * (j))
#define XB_TOP      3328
#define XB_TOPGEN   3392
#define XCD_BAR_WORDS 3456
#define XB_GCNT(j)  (3456 + 64 * (j))
#define XB_LATE     4700
#define XB_XTAB     4096
#define XB_SPIN_CAP (1u << 18)
__device__ __forceinline__ unsigned xb_ld(unsigned* p)              { return __hip_atomic_load(p, __ATOMIC_RELAXED, __HIP_MEMORY_SCOPE_AGENT); }
__device__ __forceinline__ unsigned xb_add(unsigned* p, unsigned v) { return __hip_atomic_fetch_add(p, v, __ATOMIC_RELAXED, __HIP_MEMORY_SCOPE_AGENT); }
__device__ __forceinline__ unsigned xb_xcc_id() { return (unsigned)__builtin_amdgcn_s_getreg((3 << 11) | 20) & 0xFu; }
#define XB_SPIN(cond, bar) do { unsigned _sp = 0; while (cond) { __builtin_amdgcn_s_sleep(1); \
    if ((++_sp & 255u) == 0u) { if (xb_ld(&(bar)[XB_TMO])) break; if (_sp > XB_SPIN_CAP) { atomicAdd(&(bar)[XB_TMO], 1u); break; } } } } while (0)
struct XcdBarrier { unsigned* bar; unsigned x; volatile LAS unsigned* st; };
__device__ __forceinline__ XcdBarrier xcd_barrier_post(unsigned* bar, volatile LAS unsigned* st) {
    XcdBarrier b; b.bar = bar; b.x = xb_xcc_id(); b.st = st;
    if (threadIdx.x == 0) { (void)xb_add(&bar[XB_XCNT(b.x)], 1u); __hip_atomic_store(&bar[XB_XTAB + blockIdx.x], b.x + 1u, RLX_AGENT); }
    return b;
}
__device__ __forceinline__ void xcd_barrier_complete(unsigned* bar, unsigned x, unsigned& nloc, unsigned& nx) {
    const unsigned G = gridDim.x * gridDim.y * gridDim.z;
    unsigned sum, cnt, mine, sp = 0u;
    for (;;) {
        sum = 0u; cnt = 0u; mine = 0u;
#pragma unroll
        for (unsigned j = 0; j < 16; ++j) { const unsigned c = xb_ld(&bar[XB_XCNT(j)]); sum += c; cnt += (c > 0u) ? 1u : 0u; mine = (j == x) ? c : mine; }
        if (sum == G) break;
        __builtin_amdgcn_s_sleep(1);
        if ((++sp & 255u) == 0u) { if (xb_ld(&bar[XB_TMO])) break; if (sp > XB_SPIN_CAP) { atomicAdd(&bar[XB_TMO], 1u); break; } }
    }
    nloc = mine > 0u ? mine : 1u; nx = cnt > 0u ? cnt : 1u;
}
__device__ __forceinline__ void xcd_barrier(const XcdBarrier& b, bool global = false) {
    asm volatile("s_waitcnt vmcnt(0)" ::: "memory");
    __syncthreads();
    if (threadIdx.x == 0) {
        unsigned* bar = b.bar;
        __builtin_amdgcn_s_waitcnt(0);
        if (!global && b.st[2] != 0u) {
            const unsigned gen = b.st[3]; b.st[3] = gen + 1u;
            unsigned* gc = &bar[XB_GCNT(blockIdx.x & 7u)];
            (void)xb_add(gc, 1u);
            asm volatile("buffer_inv sc1" ::: "memory");
            XB_SPIN(xb_ld(gc) < 32u * (gen + 1u), bar);
            asm volatile("s_waitcnt vmcnt(0)" ::: "memory");
        } else {
        unsigned nloc = b.st[0], nx = b.st[1];
        if (nloc == 0u) { xcd_barrier_complete(bar, b.x, nloc, nx); b.st[0] = nloc; b.st[1] = nx; }
        const unsigned old = xb_add(&bar[XB_XSUB(b.x)], 1u);
        const unsigned gen = old / nloc;
        if (old + 1u == (gen + 1u) * nloc) {
            __builtin_amdgcn_fence(__ATOMIC_RELEASE, "agent");
            asm volatile("s_waitcnt vmcnt(0)" ::: "memory");
            const unsigned og = xb_add(&bar[XB_TOP], 1u);
            const unsigned tg = og / nx;
            if (og + 1u == (tg + 1u) * nx) xb_add(&bar[XB_TOPGEN], 1u);
            else XB_SPIN(xb_ld(&bar[XB_TOPGEN]) == tg, bar);
            __builtin_amdgcn_fence(__ATOMIC_ACQUIRE, "agent");
            xb_add(&bar[XB_XGEN(b.x)], 1u);
            asm volatile("s_waitcnt vmcnt(0)" ::: "memory");
        } else {
            XB_SPIN(xb_ld(&bar[XB_XGEN(b.x)]) == gen, bar);
            __builtin_amdgcn_fence(__ATOMIC_ACQUIRE, "agent");
            asm volatile("s_waitcnt vmcnt(0)" ::: "memory");
        }
        }
    }
    __syncthreads();
}

__device__ __forceinline__ float wave_sum(float v) {
#pragma unroll
    for (int o = 1; o < 64; o <<= 1) v += __shfl_xor(v, o);
    return v;
}
__device__ __forceinline__ void sincos_acc(float a, float& s, float& c) {
    const double x = (double)a;
    const double n = rint(x * 0.63661977236758134308);
    double r = fma(-n, 1.5707963267948966192, x); r = fma(-n, 6.123233995736766036e-17, r);
    const double r2 = r * r;
    double sp = -2.5052108385441718775e-8; sp = fma(sp, r2, 2.7557319223985890653e-6); sp = fma(sp, r2, -1.9841269841269841270e-4); sp = fma(sp, r2, 8.3333333333333333333e-3); sp = fma(sp, r2, -1.6666666666666666667e-1);
    const double sr = fma(sp * r2, r, r);
    double cp = 2.0876756987868098979e-9; cp = fma(cp, r2, -2.7557319223985890653e-7); cp = fma(cp, r2, 2.4801587301587301587e-5); cp = fma(cp, r2, -1.3888888888888888889e-3); cp = fma(cp, r2, 4.1666666666666666667e-2); cp = fma(cp, r2, -0.5);
    const double cr = fma(cp, r2, 1.0);
    const int q = ((int)n) & 3;
    const double ss = (q & 1) ? cr : sr, cc = (q & 1) ? sr : cr;
    s = (float)((q & 2) ? -ss : ss); c = (float)(((q + 1) & 2) ? -cc : cc);
}

template <bool F8>
__device__ __forceinline__ void transpose_item(const float* W, int ldw, int k0, int srccol0, bf16* WT, int ldt, int dstrow0, LAS float* scr, int lane) {
    float wv[32];
#pragma unroll
    for (int i = 0; i < 32; ++i) wv[i] = W[(size_t)(k0 + 2 * i + (lane >> 5)) * ldw + srccol0 + (lane & 31)];
#pragma unroll
    for (int i = 0; i < 32; ++i) scr[(2 * i + (lane >> 5)) * 33 + (lane & 31)] = wv[i];
    LDS_WAIT(); asm volatile("" ::: "memory");
    const int c = lane & 7;
#pragma unroll
    for (int j = 0; j < 4; ++j) { const int n = (lane >> 3) + 8 * j; const LAS float* s = scr + (8 * c) * 33 + n;
        if constexpr (F8) { *(v2u*)((unsigned char*)WT + (size_t)(dstrow0 + n) * ldt + k0 + 8 * c) = pack8_fp8(s[0 * 33], s[1 * 33], s[2 * 33], s[3 * 33], s[4 * 33], s[5 * 33], s[6 * 33], s[7 * 33], FP8_WSCALE); }
        else { v4u o; o.x = pk2(s[0 * 33], s[1 * 33]); o.y = pk2(s[2 * 33], s[3 * 33]); o.z = pk2(s[4 * 33], s[5 * 33]); o.w = pk2(s[6 * 33], s[7 * 33]);
            *(v4u*)(WT + (size_t)(dstrow0 + n) * ldt + k0 + 8 * c) = o; } }
    LDS_WAIT(); asm volatile("" ::: "memory");
}
__device__ __forceinline__ void tp_load(const float* W, int ldw, int k0, int sc, int lane, float (&wv)[32]) {
#pragma unroll
    for (int i = 0; i < 32; ++i) wv[i] = W[(size_t)(k0 + 2 * i + (lane >> 5)) * ldw + sc + (lane & 31)];
}
__device__ __forceinline__ void tp_store(const float (&wv)[32], bf16* WT, int ldt, int k0, int dr, LAS float* scr, int lane) {
#pragma unroll
    for (int i = 0; i < 32; ++i) scr[(2 * i + (lane >> 5)) * 33 + (lane & 31)] = wv[i];
    LDS_WAIT(); asm volatile("" ::: "memory");
    const int c = lane & 7;
#pragma unroll
    for (int j = 0; j < 4; ++j) { const int n = (lane >> 3) + 8 * j; const LAS float* sp = scr + (8 * c) * 33 + n;
        v4u o; o.x = pk2(sp[0 * 33], sp[1 * 33]); o.y = pk2(sp[2 * 33], sp[3 * 33]); o.z = pk2(sp[4 * 33], sp[5 * 33]); o.w = pk2(sp[6 * 33], sp[7 * 33]);
        *(v4u*)(WT + (size_t)(dr + n) * ldt + k0 + 8 * c) = o; }
    LDS_WAIT(); asm volatile("" ::: "memory");
}
struct TJob { const float* src; bf16* dst; int ldw, K, Nd, mode; };
struct Args { const void* in[21]; float* out; unsigned char* ws; int ph_lo, ph_hi; };

__device__ __forceinline__ TJob get_job(const Args& a, int j) {
    unsigned char* ws = a.ws; TJob t;
    if (j == 0)      { t.src = (const float*)a.in[7];  t.dst = (bf16*)(ws + WS_W_RET_IN);  t.ldw = RET_IN;   t.K = D;        t.Nd = RET_IN;   t.mode = 0; }
    else if (j == 1) { t.src = (const float*)a.in[8];  t.dst = (bf16*)(ws + WS_W_RET_OUT); t.ldw = D;        t.K = RET_VW;   t.Nd = D;        t.mode = 0; }
    else if (j == 2) { t.src = (const float*)a.in[9];  t.dst = (bf16*)(ws + WS_W_CONV_IN); t.ldw = CONV_INW; t.K = D;        t.Nd = CONV_INW; t.mode = 2; }
    else if (j == 3) { t.src = (const float*)a.in[11]; t.dst = (bf16*)(ws + WS_W_CONV_OUT); t.ldw = D;       t.K = D;        t.Nd = D;        t.mode = 0; }
    else if (j == 4) { t.src = (const float*)a.in[12]; t.dst = (bf16*)(ws + WS_W_GLA_IN);  t.ldw = GLA_INW;  t.K = D;        t.Nd = GLA_MAIN; t.mode = 0; }
    else if (j == 5) { t.src = (const float*)a.in[15]; t.dst = (bf16*)(ws + WS_W_GLA_OUT); t.ldw = D;        t.K = D;        t.Nd = D;        t.mode = 0; }
    else if (j < 10) { const int g = j - 6;  t.src = (const float*)a.in[16] + (size_t)g * 512 * 512; t.dst = (bf16*)(ws + WS_W_POOL) + (size_t)g * 512 * 512; t.ldw = 512; t.K = 512; t.Nd = 512; t.mode = 0; }
    else if (j < 14) { const int l = j - 10; t.src = (const float*)a.in[18] + (size_t)l * D * FF2;   t.dst = (bf16*)(ws + WS_W_FFN_IN) + (size_t)l * FF2 * D;  t.ldw = FF2; t.K = D;   t.Nd = FF2; t.mode = 1; }
    else             { const int l = j - 14; t.src = (const float*)a.in[19] + (size_t)l * FF * D;    t.dst = (bf16*)(ws + WS_W_FFN_OUT) + (size_t)l * D * FF;  t.ldw = D;   t.K = FF;  t.Nd = D;   t.mode = 0; }
    return t;
}
constexpr int NJOBS = 18;
__device__ __forceinline__ int job_src_col(int mode, int n) {
    if (mode == 1) { const int tile = n >> 8, r = n & 255; return r < 128 ? tile * 128 + r : FF + tile * 128 + (r - 128); }
    if (mode == 2) { if (n < 2048) return n; const int nn = n - 2048, tile = nn >> 8, r = nn & 255; return r < 128 ? 2048 + tile * 128 + r : 4096 + tile * 128 + (r - 128); }
    return n;
}

template <bool DEEP = false>
__device__ __forceinline__ void transposes_masked(const Args& a, LAS unsigned char* lds, int lane, int wave, unsigned mask, int wid, int nw) {
    LAS float* scr = (LAS float*)(lds + wave * 16384);
    int base = 0;
    for (int j = 0; j < NJOBS; ++j) {
        if (!((mask >> j) & 1u)) continue;
        const TJob t = get_job(a, j);
        const int nblk = t.Nd / 32, nitems = (t.K / 64) * nblk;
        int it = base + ((wid - base % nw) + nw) % nw;
        const bool f8 = (j >= 10 && j < 14) && ((FP8_FFN_MASK >> (j - 10)) & 1);
        if constexpr (DEEP) if (!f8) {
            const int e0 = base + nitems;
            float wa[32], wb[32], wc[32];
#define TP_LD(IT, BUF) do { const int r_ = (IT) - base; tp_load(t.src, t.ldw, (r_ / nblk) * 64, job_src_col(t.mode, (r_ % nblk) * 32), lane, BUF); } while (0)
#define TP_ST(IT, BUF) do { const int r_ = (IT) - base; tp_store(BUF, t.dst, t.K, (r_ / nblk) * 64, (r_ % nblk) * 32, scr, lane); } while (0)
            if (it < e0) TP_LD(it, wa);
            if (it + nw < e0) TP_LD(it + nw, wb);
            for (;;) {
                if (it >= e0) break; if (it + 2 * nw < e0) TP_LD(it + 2 * nw, wc); TP_ST(it, wa); it += nw;
                if (it >= e0) break; if (it + 2 * nw < e0) TP_LD(it + 2 * nw, wa); TP_ST(it, wb); it += nw;
                if (it >= e0) break; if (it + 2 * nw < e0) TP_LD(it + 2 * nw, wb); TP_ST(it, wc); it += nw;
            }
#undef TP_LD
#undef TP_ST
        }
        for (; it < base + nitems; it += nw) { const int r = it - base, kb = r / nblk, nb = r % nblk;
            if (f8) transpose_item<true>(t.src, t.ldw, kb * 64, job_src_col(t.mode, nb * 32), t.dst, t.K, nb * 32, scr, lane);
            else transpose_item<false>(t.src, t.ldw, kb * 64, job_src_col(t.mode, nb * 32), t.dst, t.K, nb * 32, scr, lane); }
        base += nitems;
    }
}
constexpr unsigned ALL_JOBS = (1u << NJOBS) - 1u;
constexpr unsigned LATE_JOBS = (0xFu << 6) | (1u << 13) | (1u << 17) | (1u << 16) | (1u << 12);

__device__ __forceinline__ void prologue_phase(const Args& a, LAS unsigned char* lds, int tid, int lane, int wave, int vcu, int G, bool late_w) {
    unsigned char* ws = a.ws;
    {
        LAS float* cact = (LAS float*)lds;
        LAS float* red = (LAS float*)(lds + 65536);
        const float* c = (const float*)a.in[1];
        for (int i = tid; i < 8 * 2048; i += 512) { const int b = i >> 11, k = i & 2047; const float v = c[i]; cact[k * 8 + b] = v / (1.0f + __expf(-v)); }
        __syncthreads();
        const float* wmod = (const float*)a.in[3]; const float* bmod = (const float*)a.in[4]; float* mod = (float*)(ws + WS_MOD);
        for (int item = vcu; item < 4 * 48; item += G) {
            const int l = item / 48, n0 = (item % 48) * 256;
            const float* W = wmod + (size_t)l * D * MODW + n0 + 4 * lane;
            f32x4 acc[8];
#pragma unroll
            for (int b = 0; b < 8; ++b) acc[b] = (f32x4){0.f, 0.f, 0.f, 0.f};
            for (int kk = 0; kk < 256; kk += 8) {
                f32x4 w[8];
#pragma unroll
                for (int u = 0; u < 8; ++u) w[u] = *(const f32x4*)(W + (size_t)(wave * 256 + kk + u) * MODW);
#pragma unroll
                for (int u = 0; u < 8; ++u) { const int k = wave * 256 + kk + u; const f32x4 c0 = *(const LAS f32x4*)(cact + k * 8), c1 = *(const LAS f32x4*)(cact + k * 8 + 4);
                    acc[0] += w[u] * c0[0]; acc[1] += w[u] * c0[1]; acc[2] += w[u] * c0[2]; acc[3] += w[u] * c0[3];
                    acc[4] += w[u] * c1[0]; acc[5] += w[u] * c1[1]; acc[6] += w[u] * c1[2]; acc[7] += w[u] * c1[3]; }
            }
#pragma unroll
            for (int b = 0; b < 8; ++b) *(LAS f32x4*)(red + (wave * 8 + b) * 256 + 4 * lane) = acc[b];
            __syncthreads();
            { const int b = tid >> 6; f32x4 s = *(const f32x4*)(bmod + (size_t)l * MODW + n0 + 4 * lane);
#pragma unroll
              for (int w = 0; w < 8; ++w) s += *(const LAS f32x4*)(red + (w * 8 + b) * 256 + 4 * lane);
              *(f32x4*)(mod + (size_t)(l * 8 + b) * MODW + n0 + 4 * lane) = s; }
            __syncthreads();
        }
        __syncthreads();
    }
    const int gw = vcu * NWAVES + wave, NGW = G * NWAVES;
    transposes_masked(a, lds, lane, wave, late_w ? (ALL_JOBS & ~LATE_JOBS) : ALL_JOBS, gw, NGW);
    const int gtid = vcu * 512 + tid, NT = G * 512;
    { const float* w = (const float*)a.in[12]; float* wzt = (float*)(ws + WS_WZT);
      for (int i = gtid; i < 16 * 2048; i += NT) { const int r = i >> 11, k = i & 2047; wzt[i] = w[(size_t)k * GLA_INW + GLA_MAIN + r]; } }
    { const int* pos = (const int*)a.in[2]; float* ct = (float*)(ws + WS_COS); float* st = (float*)(ws + WS_SIN);
      for (int i = gtid; i < M * 128; i += NT) { const int m = i >> 7, j = i & 127;
          const float lin = (float)j * (1.0f / 127.0f); const float inv = exp2f(-lin * 13.287712379549449f);
          const float ang = (float)pos[m] * inv; float s, c; sincos_acc(ang, s, c); ct[i] = c; st[i] = s; } }
}

__device__ __forceinline__ float reduce16(const float (&p)[16], int lane) {
    float a[8], b[4], c[2];
    { const bool hi = (lane & 32) != 0;
#pragma unroll
      for (int k = 0; k < 8; ++k) { const float send = hi ? p[k] : p[k + 8], keep = hi ? p[k + 8] : p[k]; a[k] = keep + __shfl_xor(send, 32); } }
    { const bool hi = (lane & 16) != 0;
#pragma unroll
      for (int k = 0; k < 4; ++k) { const float send = hi ? a[k] : a[k + 4], keep = hi ? a[k + 4] : a[k]; b[k] = keep + __shfl_xor(send, 16); } }
    { const bool hi = (lane & 8) != 0;
#pragma unroll
      for (int k = 0; k < 2; ++k) { const float send = hi ? b[k] : b[k + 2], keep = hi ? b[k + 2] : b[k]; c[k] = keep + __shfl_xor(send, 8); } }
    const bool hi4 = (lane & 4) != 0; const float send = hi4 ? c[0] : c[1], keep = hi4 ? c[1] : c[0];
    float d = keep + __shfl_xor(send, 4);
    d += __shfl_xor(d, 2); d += __shfl_xor(d, 1);
    return d;
}
template <bool ZP, bool XF32, bool OUT8 = false>
__device__ __forceinline__ void norm_phase(LAS unsigned char* lds, const void* xin, const float* gain, const float* sh, const float* sc, bf16* hout, const float* wzt, float* zout, int lane, int wave, int vcu, int G) {
    const int gw = vcu * NWAVES + wave, NGW = G * NWAVES;
    LAS float* wl = (LAS float*)lds;
    if constexpr (ZP) {
        for (int i = threadIdx.x; i < 8192; i += NWAVES * 64) { const int ln = i & 63, half = (i >> 6) & 1, j = (i >> 7) & 3, rr = i >> 9;
            *(LAS f32x4*)(wl + i * 4) = *(const f32x4*)(wzt + (size_t)rr * D + 512 * j + 8 * ln + 4 * half); }
        __syncthreads();
    }
    const bool xdeal = (G == 256);
    const int nit = xdeal ? 4 : (M + 2 * NGW - 1) / (2 * NGW);
    for (int it_ = 0; it_ < nit; ++it_) {
        const int m0 = xdeal ? 2048 * (gw >> 8) + 2 * (gw & 255) + 512 * it_ : 2 * gw + it_ * 2 * NGW;
        if (m0 >= M) break;
        f32x4 v[2][4][2]; float ss[2] = {0.f, 0.f};
#pragma unroll
        for (int r = 0; r < 2; ++r)
#pragma unroll
            for (int j = 0; j < 4; ++j) {
                if constexpr (XF32) { const float* xr = (const float*)xin + (size_t)(m0 + r) * D + 8 * lane; v[r][j][0] = *(const f32x4*)(xr + 512 * j); v[r][j][1] = *(const f32x4*)(xr + 512 * j + 4); }
                else { float f[8]; unpack8(*(const v4u*)((const bf16*)xin + (size_t)(m0 + r) * D + 8 * lane + 512 * j), f); v[r][j][0] = (f32x4){f[0], f[1], f[2], f[3]}; v[r][j][1] = (f32x4){f[4], f[5], f[6], f[7]}; } }
#pragma unroll
        for (int r = 0; r < 2; ++r)
#pragma unroll
            for (int j = 0; j < 4; ++j)
#pragma unroll
                for (int e = 0; e < 4; ++e) ss[r] += v[r][j][0][e] * v[r][j][0][e] + v[r][j][1][e] * v[r][j][1][e];
#pragma unroll
        for (int r = 0; r < 2; ++r) { const int m = m0 + r, b = m >> 11;
            const float rstd = rsqrtf(wave_sum(ss[r]) * (1.0f / D) + EPS);
#pragma unroll
            for (int j = 0; j < 4; ++j) { const int col = 512 * j + 8 * lane;
#pragma unroll
                for (int q = 0; q < 2; ++q) { const f32x4 gg = *(const f32x4*)(gain + col + 4 * q), s1 = *(const f32x4*)(sc + (size_t)b * MODW + col + 4 * q), s0 = *(const f32x4*)(sh + (size_t)b * MODW + col + 4 * q);
                    v[r][j][q] = (v[r][j][q] * rstd * gg) * (s1 + 1.0f) + s0; }
                if constexpr (OUT8) { *(v2u*)((unsigned char*)hout + (size_t)m * D + col) = pack8_fp8(v[r][j][0][0], v[r][j][0][1], v[r][j][0][2], v[r][j][0][3], v[r][j][1][0], v[r][j][1][1], v[r][j][1][2], v[r][j][1][3], FP8_ASCALE); }
                else { v4u o; o.x = pk2(v[r][j][0][0], v[r][j][0][1]); o.y = pk2(v[r][j][0][2], v[r][j][0][3]); o.z = pk2(v[r][j][1][0], v[r][j][1][1]); o.w = pk2(v[r][j][1][2], v[r][j][1][3]);
                    *(v4u*)(hout + (size_t)m * D + col) = o; } }
        }
        if constexpr (ZP) {
            float p0[16], p1[16];
#pragma unroll
            for (int rr = 0; rr < 16; ++rr) { p0[rr] = 0.f; p1[rr] = 0.f;
#pragma unroll
                for (int j = 0; j < 4; ++j) { const f32x4 w0 = *(const LAS f32x4*)(wl + (((rr * 4 + j) * 2 + 0) * 64 + lane) * 4), w1 = *(const LAS f32x4*)(wl + (((rr * 4 + j) * 2 + 1) * 64 + lane) * 4);
#pragma unroll
                    for (int e = 0; e < 4; ++e) { p0[rr] += v[0][j][0][e] * w0[e] + v[0][j][1][e] * w1[e]; p1[rr] += v[1][j][0][e] * w0[e] + v[1][j][1][e] * w1[e]; } } }
            const float z0 = reduce16(p0, lane), z1 = reduce16(p1, lane);
            if ((lane & 3) == 0) { const int rr = ((lane >> 5) & 1) * 8 + ((lane >> 4) & 1) * 4 + ((lane >> 3) & 1) * 2 + ((lane >> 2) & 1);
                zout[(size_t)m0 * 16 + rr] = z0; zout[(size_t)(m0 + 1) * 16 + rr] = z1; }
        }
    }
}
__device__ __forceinline__ void final_norm_phase(const bf16* xin, const float* gain, float* out, int lane, int wave, int vcu, int G) {
    const int gw = vcu * NWAVES + wave, NGW = G * NWAVES;
    const bool xdeal = (G == 256);
    const int nit = xdeal ? 4 : (M + 2 * NGW - 1) / (2 * NGW);
    for (int it_ = 0; it_ < nit; ++it_) {
        const int m0 = xdeal ? 2048 * (gw >> 8) + 2 * (gw & 255) + 512 * it_ : 2 * gw + it_ * 2 * NGW;
        if (m0 >= M) break;
        float v[2][4][8]; float ss[2] = {0.f, 0.f};
#pragma unroll
        for (int r = 0; r < 2; ++r)
#pragma unroll
            for (int j = 0; j < 4; ++j) unpack8(*(const v4u*)(xin + (size_t)(m0 + r) * D + 8 * lane + 512 * j), v[r][j]);
#pragma unroll
        for (int r = 0; r < 2; ++r)
#pragma unroll
            for (int j = 0; j < 4; ++j)
#pragma unroll
                for (int e = 0; e < 8; ++e) ss[r] += v[r][j][e] * v[r][j][e];
#pragma unroll
        for (int r = 0; r < 2; ++r) { const int m = m0 + r;
            const float rstd = rsqrtf(wave_sum(ss[r]) * (1.0f / D) + EPS);
#pragma unroll
            for (int j = 0; j < 4; ++j) { const int col = 512 * j + 8 * lane; const f32x4 g0 = *(const f32x4*)(gain + col), g1 = *(const f32x4*)(gain + col + 4);
                *(f32x4*)(out + (size_t)m * D + col) = (f32x4){v[r][j][0], v[r][j][1], v[r][j][2], v[r][j][3]} * rstd * g0;
                *(f32x4*)(out + (size_t)m * D + col + 4) = (f32x4){v[r][j][4], v[r][j][5], v[r][j][6], v[r][j][7]} * rstd * g1; } }
    }
}
__device__ __forceinline__ void post_phase(bf16* O, const bf16* Gt, int nheads, int lane, int wave, int vcu, int G) {
    const int gw = vcu * NWAVES + wave, NGW = G * NWAVES, nitems = M * nheads;
    const bool xdeal = (G == 256);
    const int nit = xdeal ? 2 * nheads : (nitems + 4 * NGW - 1) / (4 * NGW);
    for (int it_ = 0; it_ < nit; ++it_) {
        const int it0 = xdeal ? (gw >> 8) * SEQ * nheads + 4 * (gw & 255) + 1024 * it_ : 4 * gw + it_ * 4 * NGW;
        if (it0 >= nitems) break;
        v4u ov[4], gv[4];
#pragma unroll
        for (int u = 0; u < 4; ++u) { const size_t off = (size_t)(it0 + u) * 512 + 8 * lane; ov[u] = *(const v4u*)(O + off); gv[u] = *(const v4u*)(Gt + off); }
#pragma unroll
        for (int u = 0; u < 4; ++u) { const size_t off = (size_t)(it0 + u) * 512 + 8 * lane;
            float o[8], g[8]; unpack8(ov[u], o); unpack8(gv[u], g);
            float ss = 0.f;
#pragma unroll
            for (int e = 0; e < 8; ++e) ss += o[e] * o[e];
            const float rstd = rsqrtf(wave_sum(ss) * (1.0f / 512.0f) + EPS);
            v4u w; w.x = pk2(g[0] * o[0] * rstd, g[1] * o[1] * rstd); w.y = pk2(g[2] * o[2] * rstd, g[3] * o[3] * rstd); w.z = pk2(g[4] * o[4] * rstd, g[5] * o[5] * rstd); w.w = pk2(g[6] * o[6] * rstd, g[7] * o[7] * rstd);
            *(v4u*)(O + off) = w; }
    }
}
__device__ __forceinline__ void conv_phase(const bf16* Bg, const bf16* CU, bf16* Y, const float* cw, int tid, int vcu, int G) {
    const int gtid = vcu * 512 + tid, NT = G * 512;
    for (int task = gtid; task < 256 * 512; task += NT) {
        const int cg = task & 255, run = task >> 8, m0 = run * 32, col = cg * 8;
        float w0[8], w1[8], w2[8], p2[8], p1[8];
#pragma unroll
        for (int e = 0; e < 8; ++e) { w0[e] = cw[col + e]; w1[e] = cw[D + col + e]; w2[e] = cw[2 * D + col + e]; p2[e] = 0.f; p1[e] = 0.f; }
        if ((m0 & (SEQ - 1)) != 0) { unpack8(*(const v4u*)(CU + (size_t)(m0 - 2) * D + col), p2); unpack8(*(const v4u*)(CU + (size_t)(m0 - 1) * D + col), p1); }
        for (int r0 = 0; r0 < 32; r0 += 8) { v4u cw[8], bw[8];
#pragma unroll
            for (int u = 0; u < 8; ++u) { const size_t off = (size_t)(m0 + r0 + u) * D + col; cw[u] = *(const v4u*)(CU + off); bw[u] = *(const v4u*)(Bg + off); }
#pragma unroll
            for (int u = 0; u < 8; ++u) { const size_t off = (size_t)(m0 + r0 + u) * D + col;
                float cu[8], bg[8], y[8]; unpack8(cw[u], cu); unpack8(bw[u], bg);
#pragma unroll
                for (int e = 0; e < 8; ++e) { y[e] = bg[e] * (w0[e] * p2[e] + w1[e] * p1[e] + w2[e] * cu[e]); p2[e] = p1[e]; p1[e] = cu[e]; }
                v4u w; w.x = pk2(y[0], y[1]); w.y = pk2(y[2], y[3]); w.z = pk2(y[4], y[5]); w.w = pk2(y[6], y[7]);
                *(v4u*)(Y + off) = w; } }
    }
}
__device__ __forceinline__ void pool_phase(const bf16* H, bf16* MX, int tid, int vcu, int G) {
    const int gtid = vcu * 512 + tid, NT = G * 512;
    for (int task = gtid; task < 256 * 512; task += NT) {
        const int cg = task & 255, run = task >> 8, m0 = run * 32, col = cg * 8, win = 2 << (cg >> 6), t0 = m0 & (SEQ - 1);
        const bf16* hp = H + (size_t)m0 * D + col;
        float sum[8];
#pragma unroll
        for (int e = 0; e < 8; ++e) sum[e] = 0.f;
        if (t0 != 0) {
            v4u pw[16];
#pragma unroll
            for (int j = 0; j < 16; ++j) pw[j] = (j < win) ? *(const v4u*)(hp - (ptrdiff_t)(j + 1) * D) : (v4u){0u, 0u, 0u, 0u};
#pragma unroll
            for (int j = 0; j < 16; ++j) { float f[8]; unpack8(pw[j], f);
#pragma unroll
                for (int e = 0; e < 8; ++e) sum[e] += f[e]; }
        }
        for (int r0 = 0; r0 < 32; r0 += 8) {
            v4u cw[8], ow[8];
#pragma unroll
            for (int u = 0; u < 8; ++u) { const int r = r0 + u; cw[u] = *(const v4u*)(hp + (size_t)r * D);
                ow[u] = (t0 + r - win >= 0) ? *(const v4u*)(hp + (ptrdiff_t)(r - win) * D) : (v4u){0u, 0u, 0u, 0u}; }
#pragma unroll
            for (int u = 0; u < 8; ++u) { const int r = r0 + u, t = t0 + r; const int cnt = (t + 1 < win) ? t + 1 : win;
                float cur[8], old[8], y[8]; unpack8(cw[u], cur); unpack8(ow[u], old);
                const float inv = 1.0f / (float)cnt;
#pragma unroll
                for (int e = 0; e < 8; ++e) { sum[e] += cur[e] - old[e]; y[e] = sum[e] * inv - cur[e]; }
                v4u w; w.x = pk2(y[0], y[1]); w.y = pk2(y[2], y[3]); w.z = pk2(y[4], y[5]); w.w = pk2(y[6], y[7]);
                *(v4u*)(MX + (size_t)(m0 + r) * D + col) = w; }
        }
    }
}

typedef short s16x4 __attribute__((ext_vector_type(4)));
typedef short bf16x8s __attribute__((ext_vector_type(8)));
typedef float f32x2s __attribute__((ext_vector_type(2)));
typedef __bf16 bf16x2_t __attribute__((ext_vector_type(2)));
__device__ __forceinline__ unsigned cvt2(float a, float b) { f32x2s v = {a, b}; bf16x2_t r = __builtin_convertvector(v, bf16x2_t); return __builtin_bit_cast(unsigned, r); }
__device__ __forceinline__ s16x4 ldtr(LAS const unsigned char* p) { return __builtin_bit_cast(s16x4, __builtin_amdgcn_ds_read_tr16_b64_v4i16((LAS s16x4*)p)); }
constexpr int SC_QS = 528, SC_KS = 544, SC_VS = 288, SC_PS = 160, SC_OS = 272;
constexpr int SC_QI = 0, SC_KI = SC_QI + 64 * SC_QS, SC_VI = SC_KI + 64 * SC_KS, SC_PI = SC_VI + 64 * SC_VS, SC_OI = SC_PI + 64 * SC_PS, SC_EI = SC_OI + 64 * SC_OS, SC_END = SC_EI + 1024;
static_assert(SC_END <= RING_BYTES, "scan LDS map");
#define SC_BAR() do { asm volatile("s_waitcnt lgkmcnt(0)" ::: "memory"); __builtin_amdgcn_s_barrier(); asm volatile("" ::: "memory"); } while (0)
template <bool GLA>
__device__ __forceinline__ void scan_item2(LAS unsigned char* lds, const bf16* Qd, const bf16* Kd, const bf16* V, bf16* O, const float* EG, int ldqk, int ldv, int b, int h, int dvs, float e_const, int tid) {
    const int lane = tid & 63, w = __builtin_amdgcn_readfirstlane(tid >> 6), fr = lane & 15, fq = lane >> 4, q4 = fr >> 2, p4 = fr & 3;
    if (w >= 4) {
        const int t2 = tid - 256, cw = w - 4;
        const bf16* qg = Qd + (size_t)(b * SEQ + (t2 >> 5)) * ldqk + h * 256 + (t2 & 31) * 8;
        const bf16* kg = Kd + (size_t)(b * SEQ + (t2 >> 5)) * ldqk + h * 256 + (t2 & 31) * 8;
        const bf16* vg = V + (size_t)(b * SEQ + (t2 >> 4)) * ldv + h * 512 + dvs * 128 + (t2 & 15) * 8;
        const float* eg = GLA ? EG + (size_t)(b * 32) * 1024 + h * 256 + (t2 & 63) * 4 : nullptr;
        LAS unsigned char* qw = lds + SC_QI + (t2 >> 5) * SC_QS + (t2 & 31) * 16;
        LAS unsigned char* kw = lds + SC_KI + (t2 >> 5) * SC_KS + (t2 & 31) * 16;
        LAS unsigned char* vw = lds + SC_VI + (t2 >> 4) * SC_VS + (t2 & 15) * 16;
        v4u qr[8], kr[8], vr[4]; f32x4 er = (f32x4){0.f, 0.f, 0.f, 0.f};
#pragma unroll
        for (int k = 0; k < 8; ++k) { qr[k] = *(const v4u*)(qg + (size_t)(8 * k) * ldqk); kr[k] = *(const v4u*)(kg + (size_t)(8 * k) * ldqk); }
#pragma unroll
        for (int k = 0; k < 4; ++k) vr[k] = *(const v4u*)(vg + (size_t)(16 * k) * ldv);
        if (GLA && t2 < 64) er = *(const f32x4*)eg;
        for (int c = 0; c < SEQ / 64; ++c) {
#pragma unroll
            for (int k = 0; k < 8; ++k) { *(LAS v4u*)(qw + 8 * k * SC_QS) = qr[k]; *(LAS v4u*)(kw + 8 * k * SC_KS) = kr[k]; }
#pragma unroll
            for (int k = 0; k < 4; ++k) *(LAS v4u*)(vw + 16 * k * SC_VS) = vr[k];
            if (GLA && t2 < 64) *(LAS f32x4*)(lds + SC_EI + t2 * 16) = er;
            SC_BAR();
            if (c + 1 < SEQ / 64) { const size_t adv = (size_t)(c + 1) * 64;
#pragma unroll
                for (int k = 0; k < 8; ++k) { qr[k] = *(const v4u*)(qg + (adv + 8 * k) * ldqk); kr[k] = *(const v4u*)(kg + (adv + 8 * k) * ldqk); }
#pragma unroll
                for (int k = 0; k < 4; ++k) vr[k] = *(const v4u*)(vg + (adv + 16 * k) * ldv);
                if (GLA && t2 < 64) er = *(const f32x4*)(eg + (size_t)(c + 1) * 1024); }
            f32x4 sa[4];
#pragma unroll
            for (int tj = 0; tj < 4; ++tj) sa[tj] = (f32x4){0.f, 0.f, 0.f, 0.f};
            bf16x8s fbq[3], fak[3][4];
#define LD_S(buf, ks) do { fbq[buf] = *(const LAS bf16x8s*)(lds + SC_QI + (16 * cw + fr) * SC_QS + (32 * (ks) + 8 * fq) * 2); \
                _Pragma("unroll") for (int tj = 0; tj < 4; ++tj) fak[buf][tj] = *(const LAS bf16x8s*)(lds + SC_KI + (16 * tj + fr) * SC_KS + (32 * (ks) + 8 * fq) * 2); } while (0)
            LD_S(0, 0); LD_S(1, 1); LD_S(2, 2);
#pragma unroll
            for (int ks = 0; ks < 8; ++ks) {
                __builtin_amdgcn_sched_barrier(0);
#pragma unroll
                for (int tj = 0; tj < 4; ++tj) sa[tj] = __builtin_amdgcn_mfma_f32_16x16x32_bf16(fak[ks % 3][tj], fbq[ks % 3], sa[tj], 0, 0, 0);
                __builtin_amdgcn_sched_barrier(0);
                if (ks + 3 < 8) LD_S(ks % 3, ks + 3);
            }
#undef LD_S
            { const int i = 16 * cw + fr;
#pragma unroll
              for (int tj = 0; tj < 4; ++tj) { const int j0 = 16 * tj + 4 * fq;
                  const float p0 = (j0 + 0 <= i) ? sa[tj][0] : 0.f, p1 = (j0 + 1 <= i) ? sa[tj][1] : 0.f, p2 = (j0 + 2 <= i) ? sa[tj][2] : 0.f, p3 = (j0 + 3 <= i) ? sa[tj][3] : 0.f;
                  v2u pw; pw.x = cvt2(p0, p1); pw.y = cvt2(p2, p3);
                  *(LAS v2u*)(lds + SC_PI + i * SC_PS + j0 * 2) = pw; } }
            SC_BAR();
        }
        SC_BAR();
    } else {
        f32x4 st[16][2];
#pragma unroll
        for (int t = 0; t < 16; ++t) { st[t][0] = (f32x4){0.f, 0.f, 0.f, 0.f}; st[t][1] = (f32x4){0.f, 0.f, 0.f, 0.f}; }
        bf16* const obase = O + (size_t)(b * SEQ) * ldv + h * 512 + dvs * 128 + 32 * w;
        const unsigned ooff = (unsigned)(fr * ldv + 4 * fq) * 2u;
        for (int c = 0; c < SEQ / 64; ++c) {
            SC_BAR();
            f32x4 oa[4][2];
#pragma unroll
            for (int ti = 0; ti < 4; ++ti) { oa[ti][0] = (f32x4){0.f, 0.f, 0.f, 0.f}; oa[ti][1] = (f32x4){0.f, 0.f, 0.f, 0.f}; }
            v2u faq[2][4][2];
#define LD_C1(buf, s_) do { _Pragma("unroll") for (int ti = 0; ti < 4; ++ti) { LAS const unsigned char* ap_ = lds + SC_QI + (16 * ti + fr) * SC_QS + (32 * (s_) + 4 * fq) * 2; \
                faq[buf][ti][0] = *(const LAS v2u*)ap_; faq[buf][ti][1] = *(const LAS v2u*)(ap_ + 32); } } while (0)
            s16x4 fkt[3][2][2]; bf16x8s bv[2][2];
#define LD_C2(buf, g) do { const int ks_ = (g) >> 3, t0_ = 2 * ((g) & 7); _Pragma("unroll") for (int t = 0; t < 2; ++t) { \
                fkt[buf][t][0] = ldtr(lds + SC_KI + (32 * ks_ + 8 * fq + q4) * SC_KS + (16 * (t0_ + t) + 4 * p4) * 2); \
                fkt[buf][t][1] = ldtr(lds + SC_KI + (32 * ks_ + 8 * fq + 4 + q4) * SC_KS + (16 * (t0_ + t) + 4 * p4) * 2); } } while (0)
            LD_C1(0, 0);
#pragma unroll
            for (int s_ = 0; s_ < 8; ++s_) {
                if (s_ + 1 < 8) LD_C1((s_ + 1) & 1, s_ + 1); else { LD_C2(0, 0); LD_C2(1, 1); }
                __builtin_amdgcn_sched_barrier(0);
#pragma unroll
                for (int ct = 0; ct < 2; ++ct) {
                    v4u sbw; sbw.x = cvt2(st[2 * s_][ct][0], st[2 * s_][ct][1]); sbw.y = cvt2(st[2 * s_][ct][2], st[2 * s_][ct][3]); sbw.z = cvt2(st[2 * s_ + 1][ct][0], st[2 * s_ + 1][ct][1]); sbw.w = cvt2(st[2 * s_ + 1][ct][2], st[2 * s_ + 1][ct][3]);
                    const bf16x8s sb = __builtin_bit_cast(bf16x8s, sbw);
#pragma unroll
                    for (int ti = 0; ti < 4; ++ti) { v4u aw; aw.x = faq[s_ & 1][ti][0].x; aw.y = faq[s_ & 1][ti][0].y; aw.z = faq[s_ & 1][ti][1].x; aw.w = faq[s_ & 1][ti][1].y;
                        oa[ti][ct] = __builtin_amdgcn_mfma_f32_16x16x32_bf16(sb, __builtin_bit_cast(bf16x8s, aw), oa[ti][ct], 0, 0, 0); } }
                __builtin_amdgcn_sched_barrier(0);
            }
#pragma unroll
            for (int ks = 0; ks < 2; ++ks)
#pragma unroll
                for (int ct = 0; ct < 2; ++ct) { const s16x4 lo = ldtr(lds + SC_VI + (32 * ks + 8 * fq + q4) * SC_VS + (32 * w + 16 * ct + 4 * p4) * 2), hi = ldtr(lds + SC_VI + (32 * ks + 8 * fq + 4 + q4) * SC_VS + (32 * w + 16 * ct + 4 * p4) * 2);
                    bv[ks][ct] = __builtin_shufflevector(lo, hi, 0, 1, 2, 3, 4, 5, 6, 7); }
#pragma unroll
            for (int g = 0; g < 16; ++g) {
                if (g + 2 < 16) LD_C2((g + 2) % 3, g + 2);
                __builtin_amdgcn_sched_barrier(0);
#pragma unroll
                for (int t = 0; t < 2; ++t) { const bf16x8s ak = __builtin_shufflevector(fkt[g % 3][t][0], fkt[g % 3][t][1], 0, 1, 2, 3, 4, 5, 6, 7);
#pragma unroll
                    for (int ct = 0; ct < 2; ++ct) st[2 * (g & 7) + t][ct] = __builtin_amdgcn_mfma_f32_16x16x32_bf16(ak, bv[g >> 3][ct], st[2 * (g & 7) + t][ct], 0, 0, 0); }
                __builtin_amdgcn_sched_barrier(0);
            }
#undef LD_C1
#undef LD_C2
#pragma unroll
            for (int t = 0; t < 16; ++t) { if (GLA) { const f32x4 e4 = *(const LAS f32x4*)(lds + SC_EI + (16 * t + 4 * fq) * 4); st[t][0] = st[t][0] * e4; st[t][1] = st[t][1] * e4; } else { st[t][0] = st[t][0] * e_const; st[t][1] = st[t][1] * e_const; } }
            SC_BAR();
#pragma unroll
            for (int ks = 0; ks < 2; ++ks) { bf16x8s ap[4];
#pragma unroll
                for (int ti = 0; ti < 4; ++ti) ap[ti] = *(const LAS bf16x8s*)(lds + SC_PI + (16 * ti + fr) * SC_PS + (32 * ks + 8 * fq) * 2);
#pragma unroll
                for (int ti = 0; ti < 4; ++ti)
#pragma unroll
                    for (int ct = 0; ct < 2; ++ct) oa[ti][ct] = __builtin_amdgcn_mfma_f32_16x16x32_bf16(bv[ks][ct], ap[ti], oa[ti][ct], 0, 0, 0); }
#pragma unroll
            for (int ti = 0; ti < 4; ++ti)
#pragma unroll
                for (int ct = 0; ct < 2; ++ct) { v2u ow; ow.x = cvt2(oa[ti][ct][0], oa[ti][ct][1]); ow.y = cvt2(oa[ti][ct][2], oa[ti][ct][3]);
                    *(v2u*)((char*)(obase + ((size_t)c * 64 + 16 * ti) * ldv + 16 * ct) + ooff) = ow; }
        }
        SC_BAR();
    }
}
__device__ __forceinline__ void gla_prep_item(LAS unsigned char* lds, bf16* Q, bf16* Kb, const float* Z, const float* Wg, const float* bgate, float* EG, int item, int tid) {
    const int m0 = item * 64;
    LAS float* zs = (LAS float*)lds;
    zs[tid] = Z[(size_t)m0 * 16 + tid]; zs[tid + 512] = Z[(size_t)m0 * 16 + tid + 512];
    __syncthreads();
    const int n = 2 * tid;
    float wg0[16], wg1[16];
#pragma unroll
    for (int r = 0; r < 16; ++r) { const f32x2s wv = *(const f32x2s*)(Wg + r * GLA_QK + n); wg0[r] = wv[0]; wg1[r] = wv[1]; }
    const float bg0 = bgate[n], bg1 = bgate[n + 1];
    float b0 = 0.f, b1 = 0.f;
    unsigned* qp = (unsigned*)(Q + (size_t)m0 * GLA_QK + n); unsigned* kp = (unsigned*)(Kb + (size_t)m0 * GLA_QK + n);
    for (int t0 = 0; t0 < 64; t0 += 8) {
        unsigned qv[8], kv[8];
#pragma unroll
        for (int u = 0; u < 8; ++u) { qv[u] = qp[(size_t)(t0 + u) * (GLA_QK / 2)]; kv[u] = kp[(size_t)(t0 + u) * (GLA_QK / 2)]; }
#pragma unroll
        for (int u = 0; u < 8; ++u) { const int t = t0 + u; float x0 = bg0, x1 = bg1;
#pragma unroll
            for (int r4 = 0; r4 < 4; ++r4) { const f32x4 z4 = *(const LAS f32x4*)(zs + t * 16 + r4 * 4);
#pragma unroll
                for (int e = 0; e < 4; ++e) { x0 = fmaf(z4[e], wg0[4 * r4 + e], x0); x1 = fmaf(z4[e], wg1[4 * r4 + e], x1); } }
            b0 += (fminf(x0, 0.f) - __logf(1.0f + __expf(-fabsf(x0)))) * 0.0625f;
            b1 += (fminf(x1, 0.f) - __logf(1.0f + __expf(-fabsf(x1)))) * 0.0625f;
            const float e0 = __expf(b0), e1 = __expf(b1), i0 = __expf(-b0), i1 = __expf(-b1);
            qp[(size_t)t * (GLA_QK / 2)] = cvt2(bflo(qv[u]) * e0, bfhi(qv[u]) * e1);
            kp[(size_t)t * (GLA_QK / 2)] = cvt2(bflo(kv[u]) * i0, bfhi(kv[u]) * i1); }
    }
    *(f32x2s*)(EG + (size_t)item * GLA_QK + n) = (f32x2s){__expf(b0), __expf(b1)};
    __syncthreads();
}

constexpr int N_PHASES = 32;
__global__ void __launch_bounds__(NWAVES * 64, 2) fwd_kernel(Args args_byval) {
    (void)args_byval; const Args& args = *(const Args*)__builtin_amdgcn_kernarg_segment_ptr();
    extern __shared__ __attribute__((aligned(16))) unsigned char lds_raw[];
    LAS unsigned char* lds = (LAS unsigned char*)lds_raw;
    volatile LAS unsigned* MISC = (volatile LAS unsigned*)(lds + MISC_OFF);
    const int tid = threadIdx.x, lane = tid & 63, wave = __builtin_amdgcn_readfirstlane(tid >> 6);
    const int G = gridDim.x; const int bx = blockIdx.x; const int vcu = (G % 8 == 0) ? (bx % 8) * (G / 8) + bx / 8 : bx;
    unsigned char* ws = args.ws;
    gu32* ctl = (gu32*)(ws + WS_CTL);
    for (int u = tid; u < (LDS_BYTES - LDSCTL_OFF) / 4; u += NWAVES * 64) ((LAS unsigned*)(lds + LDSCTL_OFF))[u] = 0u;
    __syncthreads();
    XcdBarrier bar; bar.bar = (unsigned*)(ctl + CW_BAR); bar.x = 0; bar.st = nullptr;
    if (MK_ONE_LAUNCH) bar = xcd_barrier_post((unsigned*)(ctl + CW_BAR), MISC + 8);
    const int lo = args.ph_lo, hi = args.ph_hi;
    const bool late_w = MK_ONE_LAUNCH && G == 256 && lo == 0 && hi == N_PHASES;
    int ph = 0;
#define PHASE_BEGIN if (lo <= ph && ph < hi) { int tl_ = threadIdx.x; asm volatile("" : "+v"(tl_)); const int tid = tl_, lane = tl_ & 63; (void)tid; (void)lane;
#define PHASE_END   if (MK_ONE_LAUNCH && ph + 1 < hi) xcd_barrier(bar); } ++ph;
#define LATE_CONVERT() if (late_w && bx >= 128) { \
        transposes_masked<true>(args, lds, lane, wave, LATE_JOBS, (bx - 128) * NWAVES + wave, 128 * NWAVES); \
        asm volatile("s_waitcnt vmcnt(0)" ::: "memory"); __syncthreads(); \
        if (tid == 0) { __builtin_amdgcn_fence(__ATOMIC_RELEASE, "agent"); asm volatile("s_waitcnt vmcnt(0)" ::: "memory"); (void)xb_add((unsigned*)(ctl + CW_BAR) + XB_LATE, 1u); } }
#define LATE_WAIT() if (late_w) { if (tid == 0) { unsigned* lb_ = (unsigned*)(ctl + CW_BAR); XB_SPIN(xb_ld(lb_ + XB_LATE) < 128u, lb_); \
        __builtin_amdgcn_fence(__ATOMIC_ACQUIRE, "agent"); asm volatile("s_waitcnt vmcnt(0)" ::: "memory"); } __syncthreads(); }
#define PHASE_END_GRID(glob) if (MK_ONE_LAUNCH && ph + 1 < hi) xcd_barrier(bar, glob); } ++ph;

    const float* x_in = (const float*)args.in[0];
    bf16* X = (bf16*)(ws + WS_X);
    bf16* Hb = (bf16*)(ws + WS_H);
    const float* mod = (const float*)(ws + WS_MOD);
    const float* n1g = (const float*)args.in[5]; const float* n2g = (const float*)args.in[6];
    bf16* FH = (bf16*)(ws + A_FH);

    PHASE_BEGIN prologue_phase(args, lds, tid, lane, wave, vcu, G, late_w); PHASE_END
    if (MK_ONE_LAUNCH && lo == 0 && hi > 1 && wave == 0) {
        unsigned* xt = (unsigned*)(ctl + CW_BAR) + XB_XTAB;
        bool ok = (G == 256);
#pragma unroll
        for (int k = 0; k < 4; ++k) { const int e = lane + 64 * k; if (e < G) ok = ok && (xb_ld(xt + e) == xb_ld(xt + (e & 7))); }
        const bool all = __builtin_amdgcn_ballot_w64(ok) == ~0ull;
        if (tid == 0) MISC[8 + 2] = all ? 1u : 0u;
    }

#define MODP(l, idx) (mod + (size_t)(l) * 8 * MODW + (size_t)(idx) * D)
#define NORM1(l, xsrc, ZP, XF) PHASE_BEGIN norm_phase<ZP, XF>(lds, xsrc, n1g + (l) * D, MODP(l, 0), MODP(l, 1), Hb, (const float*)(ws + WS_WZT), (float*)(ws + WS_Z), lane, wave, vcu, G); PHASE_END
#define FFN(l) \
    PHASE_BEGIN if constexpr ((FP8_FFN_MASK >> (l)) & 1) norm_phase<false, false, true>(lds, X, n2g + (l) * D, MODP(l, 3), MODP(l, 4), Hb, nullptr, nullptr, lane, wave, vcu, G); \
                else norm_phase<false, false, false>(lds, X, n2g + (l) * D, MODP(l, 3), MODP(l, 4), Hb, nullptr, nullptr, lane, wave, vcu, G); PHASE_END \
    PHASE_BEGIN { if ((l) == 2) { LATE_WAIT() } } if constexpr ((FP8_FFN_MASK >> (l)) & 1) { pg8::Gemm g{Hb, (const bf16*)(ws + WS_W_FFN_IN) + (size_t)(l) * FF2 * D, M, FF2, D / 2, D / 2, D / 2, 0}; pg8::StaticOrder S; S.init(M, FF2, G, bx); \
            pg8::EpiSwigluS E{FH, FF, 1.0f / (FP8_ASCALE * FP8_WSCALE)}; pg8::gemm_phase<pg8::EpiSwigluS, pg8::StaticOrder, true, true, false, false, true>(lds, g, S, E); } \
        else { pg8::Gemm g{Hb, (const bf16*)(ws + WS_W_FFN_IN) + (size_t)(l) * FF2 * D, M, FF2, D, D, D, 0}; pg8::StaticOrder S; S.init(M, FF2, G, bx); \
            pg8::EpiSwiglu E{FH, FF, 1.0f}; pg8::gemm_phase<pg8::EpiSwiglu, pg8::StaticOrder>(lds, g, S, E); } PHASE_END \
    PHASE_BEGIN { pg8::Gemm g{FH, (const bf16*)(ws + WS_W_FFN_OUT) + (size_t)(l) * D * FF, M, D, FF, FF, FF, 0}; pg8::StaticOrder S; S.init(M, D, G, bx); \
        pg8::EpiRes<false> E{X, X, MODP(l, 5), nullptr}; pg8::gemm_phase<pg8::EpiRes<false>, pg8::StaticOrder>(lds, g, S, E); } PHASE_END_GRID((l) < DEPTH - 1)

    NORM1(0, x_in, false, true)
    PHASE_BEGIN { pg8::Gemm g{Hb, (const bf16*)(ws + WS_W_RET_IN), M, RET_IN, D, D, D, 0}; pg8::StaticOrder S; S.init(M, RET_IN, G, bx);
        pg8::EpiRetIn E{(bf16*)(ws + A_RQ), (bf16*)(ws + A_RK), (bf16*)(ws + A_RV), (bf16*)(ws + A_RG), (const float*)(ws + WS_COS), (const float*)(ws + WS_SIN)};
        pg8::gemm_phase<pg8::EpiRetIn, pg8::StaticOrder>(lds, g, S, E); } PHASE_END
#define RET_SCAN PHASE_BEGIN for (int item = bx; item < 256; item += G) { const int pr = 8 * (item & 7) + (item >> 5), dvs_ = (item >> 3) & 3, hh = pr & 7;     \
        const float l2g = log1pf(-exp2f(-5.0f - (float)hh)) * 1.4426950408889634f; \
        scan_item2<false>(lds, (const bf16*)(ws + A_RQ), (const bf16*)(ws + A_RK), (const bf16*)(ws + A_RV), (bf16*)(ws + A_RO), nullptr, 2048, 4096, pr >> 3, hh, dvs_, exp2f(64.0f * l2g), tid); } PHASE_END
    RET_SCAN
    PHASE_BEGIN post_phase((bf16*)(ws + A_RO), (const bf16*)(ws + A_RG), RET_H, lane, wave, vcu, G); PHASE_END
    PHASE_BEGIN { pg8::Gemm g{(const bf16*)(ws + A_RO), (const bf16*)(ws + WS_W_RET_OUT), M, D, RET_VW, RET_VW, RET_VW, 0}; pg8::StaticOrder S; S.init(M, D, G, bx);
        pg8::EpiRes<true> E{x_in, X, MODP(0, 2), nullptr}; pg8::gemm_phase<pg8::EpiRes<true>, pg8::StaticOrder>(lds, g, S, E); } PHASE_END
    FFN(0)
    NORM1(1, X, false, false)
    PHASE_BEGIN { pg8::Gemm g{Hb, (const bf16*)(ws + WS_W_CONV_IN), M, CONV_INW, D, D, D, 0}; pg8::StaticOrder S; S.init(M, CONV_INW, G, bx);
        pg8::EpiConvIn E{(bf16*)(ws + A_CB), (bf16*)(ws + A_CCU)}; pg8::gemm_phase<pg8::EpiConvIn, pg8::StaticOrder>(lds, g, S, E); } PHASE_END
    PHASE_BEGIN conv_phase((const bf16*)(ws + A_CB), (const bf16*)(ws + A_CCU), (bf16*)(ws + A_CY), (const float*)args.in[10], tid, vcu, G); PHASE_END
    PHASE_BEGIN { pg8::Gemm g{(const bf16*)(ws + A_CY), (const bf16*)(ws + WS_W_CONV_OUT), M, D, D, D, D, 0}; pg8::StaticOrder S; S.init(M, D, G, bx);
        pg8::EpiRes<false> E{X, X, MODP(1, 2), nullptr}; pg8::gemm_phase<pg8::EpiRes<false>, pg8::StaticOrder>(lds, g, S, E); } PHASE_END
    FFN(1)
    NORM1(2, X, true, false)
    PHASE_BEGIN { pg8::Gemm g{Hb, (const bf16*)(ws + WS_W_GLA_IN), M, GLA_MAIN, D, D, D, 0}; pg8::StaticOrder S; S.init(M, GLA_MAIN, G, bx);
        pg8::EpiGlaIn E{(bf16*)(ws + A_GQ), (bf16*)(ws + A_GK), (bf16*)(ws + A_GV), (bf16*)(ws + A_GG)}; pg8::gemm_phase<pg8::EpiGlaIn, pg8::StaticOrder>(lds, g, S, E); } PHASE_END
    PHASE_BEGIN for (int item = bx; item < 256; item += G) gla_prep_item(lds, (bf16*)(ws + A_GQ), (bf16*)(ws + A_GK), (const float*)(ws + WS_Z), (const float*)args.in[13], (const float*)args.in[14], (float*)(ws + A_GE), 32 * (item & 7) + (item >> 3), tid); PHASE_END
#define GLA_SCAN PHASE_BEGIN LATE_CONVERT() for (int item = bx; item < 128; item += G) { const int pr = 4 * (item & 7) + (item >> 5), dvs_ = (item >> 3) & 3;     \
        scan_item2<true>(lds, (const bf16*)(ws + A_GQ), (const bf16*)(ws + A_GK), (const bf16*)(ws + A_GV), (bf16*)(ws + A_GO), (const float*)(ws + A_GE), \
        1024, 2048, pr >> 2, pr & 3, dvs_, 1.0f, tid); } PHASE_END
    GLA_SCAN
    PHASE_BEGIN post_phase((bf16*)(ws + A_GO), (const bf16*)(ws + A_GG), GLA_H, lane, wave, vcu, G); PHASE_END
    PHASE_BEGIN { pg8::Gemm g{(const bf16*)(ws + A_GO), (const bf16*)(ws + WS_W_GLA_OUT), M, D, D, D, D, 0}; pg8::StaticOrder S; S.init(M, D, G, bx);
        pg8::EpiRes<false> E{X, X, MODP(2, 2), nullptr}; pg8::gemm_phase<pg8::EpiRes<false>, pg8::StaticOrder>(lds, g, S, E); } PHASE_END
    FFN(2)
    NORM1(3, X, false, false)
    PHASE_BEGIN pool_phase(Hb, (bf16*)(ws + A_PM), tid, vcu, G); PHASE_END
    PHASE_BEGIN { pg8::Gemm g{(const bf16*)(ws + A_PM), (const bf16*)(ws + WS_W_POOL), M, D, 512, D, 512, 512}; pg8::StaticOrder S; S.init(M, D, G, bx);
        pg8::EpiRes<false> E{X, X, MODP(3, 2), (const float*)args.in[17]}; pg8::gemm_phase<pg8::EpiRes<false>, pg8::StaticOrder>(lds, g, S, E); } PHASE_END
    FFN(3)
    PHASE_BEGIN final_norm_phase(X, (const float*)args.in[20], args.out, lane, wave, vcu, G); PHASE_END
#undef PHASE_BEGIN
#undef PHASE_END
#undef PHASE_END_GRID
#undef LATE_CONVERT
#undef LATE_WAIT
}

extern "C" void kernel_launch(void* const* d_in, const int* in_sizes, int n_in, void* d_out, int out_size, void* d_ws, size_t ws_size, hipStream_t stream) {
    static int grid = 0;
    if (grid == 0) {
        if (n_in != 21 || in_sizes[0] != M * D || out_size != M * D || ws_size < WS_END) { fprintf(stderr, "kernel_launch: unexpected shapes (n_in %d, in0 %d, out %d, ws %zu, need %zu); nothing launched\n", n_in, n_in > 0 ? in_sizes[0] : -1, out_size, ws_size, (size_t)WS_END); grid = -1; return; }
        int dev = 0, cus = 0, per_cu = 0;
        if (hipGetDevice(&dev) != hipSuccess || hipDeviceGetAttribute(&cus, hipDeviceAttributeMultiprocessorCount, dev) != hipSuccess) { grid = -1; return; }
        if (hipFuncSetAttribute((const void*)fwd_kernel, hipFuncAttributeMaxDynamicSharedMemorySize, LDS_BYTES) != hipSuccess) { fprintf(stderr, "kernel_launch: hipFuncSetAttribute failed\n"); grid = -1; return; }
        if (hipOccupancyMaxActiveBlocksPerMultiprocessor(&per_cu, (const void*)fwd_kernel, NWAVES * 64, LDS_BYTES) != hipSuccess || per_cu < 1)
            fprintf(stderr, "kernel_launch: note: occupancy query reports %d workgroups per CU\n", per_cu);
        (void)hipGetLastError();
        grid = cus;
    }
    if (grid < 0) return;
    if (hipMemsetAsync((char*)d_ws + WS_CTL, 0, CTL_ZERO_BYTES, stream) != hipSuccess) { fprintf(stderr, "kernel_launch: memset failed\n"); return; }
    Args a{};
    for (int i = 0; i < 21; ++i) a.in[i] = d_in[i];
    a.out = (float*)d_out; a.ws = (unsigned char*)d_ws;
#if MK_ONE_LAUNCH
    a.ph_lo = 0; a.ph_hi = N_PHASES;
    hipLaunchKernelGGL(fwd_kernel, dim3(grid), dim3(NWAVES * 64), LDS_BYTES, stream, a);
#else
    for (int p = 0; p < N_PHASES; ++p) { a.ph_lo = p; a.ph_hi = p + 1; hipLaunchKernelGGL(fwd_kernel, dim3(grid), dim3(NWAVES * 64), LDS_BYTES, stream, a); }
#endif
    const hipError_t le = hipPeekAtLastError();
    if (le != hipSuccess) fprintf(stderr, "kernel_launch: launch failed: %s\n", hipGetErrorName(le));
}
```

```cpp
#include <hip/hip_runtime.h>
#include <cstdio>
#include <cstdint>

#ifndef FP8_FFN_MASK
#define FP8_FFN_MASK 0x0
#endif
#ifndef MK_ONE_LAUNCH
#define MK_ONE_LAUNCH 1
#endif

namespace pg8 {
#define PG8_LAS __attribute__((address_space(3)))
typedef unsigned short bf16_t;
typedef short bf16x8 __attribute__((ext_vector_type(8)));
typedef float f32x4 __attribute__((ext_vector_type(4)));
typedef unsigned u32x4 __attribute__((ext_vector_type(4)));
constexpr int BM = 256, BK = 64, HALF = 128, HTB = HALF * BK * 2, STAGE_BYTES = 8 * HTB, NXCD = 8, WGM = 8;

__host__ __device__ __forceinline__ int lds_byte(int r, int c) { const int st = (r >> 4) * 2 + (c >> 5), rr = r & 15, cc = c & 31, ob = rr * 64 + cc * 2; return st * 1024 + (ob ^ (((ob >> 9) & 1) << 5)); }
__host__ __device__ __forceinline__ void stage_rc(int b, int& R, int& C) { const int st = b / 1024, sb = b % 1024, swz = sb ^ (((sb >> 9) & 1) << 5); R = (st >> 1) * 16 + swz / 64; C = (st & 1) * 32 + (swz % 64) / 2; }
__host__ __device__ __forceinline__ int perm32(int rho) { const int n = rho >> 4, i = rho & 15; return 8 * (i >> 2) + 4 * n + (i & 3); }

struct Unit { int pm, pn; };
struct Gemm { const bf16_t* A; const bf16_t* Bt; int M, N, K, lda, ldb, grp; };

struct StaticOrder {
    int nM, nN, nwg, G, c;
    __host__ __device__ void init(int M, int N, int G_, int c_) { nM = M / BM; nN = N / BM; nwg = nM * nN; G = G_; c = c_; }
    __host__ __device__ bool next(int i, Unit& u) const {
        const long L = (long)i * G + c; if (L >= nwg) return false;
        int wgid = (int)L; { const int q = nwg / NXCD, r = nwg % NXCD, xcd = wgid % NXCD, off = wgid / NXCD; wgid = (xcd < r ? xcd * (q + 1) : r * (q + 1) + (xcd - r) * q) + off; }
        const int nig = WGM * nN, gid = wgid / nig, fm = gid * WGM, gsz = (nM - fm) < WGM ? (nM - fm) : WGM;
        u.pm = fm + ((wgid % nig) % gsz); u.pn = (wgid % nig) / gsz; return true;
    }
    __device__ __forceinline__ void a_ready(const Unit&) const {}
    __device__ __forceinline__ void done(const Unit&) const {}
};

__device__ __forceinline__ unsigned cvt_pk_bf16(float lo, float hi) { unsigned r; asm volatile("v_cvt_pk_bf16_f32 %0, %1, %2" : "=v"(r) : "v"(lo), "v"(hi)); return r; }
typedef int v8i_t __attribute__((ext_vector_type(8)));
typedef int v4i_t __attribute__((ext_vector_type(4)));
__device__ __forceinline__ float silu_f(float x) { return x * __builtin_amdgcn_rcpf(1.0f + __expf(-x)); }
__device__ __forceinline__ u32x4 pack8(const f32x4& a, const f32x4& b) { u32x4 w; w.x = cvt_pk_bf16(a[0], a[1]); w.y = cvt_pk_bf16(a[2], a[3]); w.z = cvt_pk_bf16(b[0], b[1]); w.w = cvt_pk_bf16(b[2], b[3]); return w; }


template <bool SCALED>
struct EpiSwigluT {
    static constexpr bool PERM = true, AFTER_DRAIN = false; static constexpr int NST = 8;
    bf16_t* O; int ldc; float sc;
    __device__ __forceinline__ void operator()(const f32x4 (&acc)[2][2][4][2], const Unit& u, int wr, int wc, int fr, int fq) const {
        const int row0 = u.pm * BM + wr * 64 + fr, col0 = u.pn * HALF + wc * 32 + 8 * fq;
#pragma unroll
        for (int ai = 0; ai < 2; ++ai)
#pragma unroll
            for (int m = 0; m < 4; ++m) { bf16_t* rowp = O + (size_t)(row0 + ai * HALF + m * 16) * ldc + col0;
                f32x4 v0, v1;
#pragma unroll
                for (int e = 0; e < 4; ++e) { if constexpr (SCALED) { v0[e] = silu_f(acc[ai][0][m][0][e] * sc) * (acc[ai][1][m][0][e] * sc); v1[e] = silu_f(acc[ai][0][m][1][e] * sc) * (acc[ai][1][m][1][e] * sc); }
                    else { v0[e] = silu_f(acc[ai][0][m][0][e]) * acc[ai][1][m][0][e]; v1[e] = silu_f(acc[ai][0][m][1][e]) * acc[ai][1][m][1][e]; } }
                *(u32x4*)rowp = pack8(v0, v1); }
    }
};
typedef EpiSwigluT<false> EpiSwiglu;
typedef EpiSwigluT<true> EpiSwigluS;
struct EpiRetIn {
    static constexpr bool PERM = true, AFTER_DRAIN = false; static constexpr int NST = 16;
    bf16_t *Q, *Kb, *V, *G; const float *cosT, *sinT;
    __device__ __forceinline__ void operator()(const f32x4 (&acc)[2][2][4][2], const Unit& u, int wr, int wc, int fr, int fq) const {
        const int row0 = u.pm * BM + wr * 64 + fr, cl = wc * 32 + 8 * fq;
        if (u.pn < 16) {
            const bool isk = u.pn >= 8; const int head = u.pn & 7; bf16_t* base = isk ? Kb : Q;
            const float l2g = log1pf(-exp2f(-5.0f - (float)head)) * 1.4426950408889634f;
#pragma unroll
            for (int ai = 0; ai < 2; ++ai)
#pragma unroll
                for (int m = 0; m < 4; ++m) { const int row = row0 + ai * HALF + m * 16;
                    const float tcp = (float)((row & 63) + 1);
                    const float sc = isk ? 0.0625f * exp2f(-tcp * l2g) : exp2f(tcp * l2g);
                    const f32x4 c0 = *(const f32x4*)(cosT + (size_t)row * 128 + cl), c1 = *(const f32x4*)(cosT + (size_t)row * 128 + cl + 4);
                    const f32x4 s0 = *(const f32x4*)(sinT + (size_t)row * 128 + cl), s1 = *(const f32x4*)(sinT + (size_t)row * 128 + cl + 4);
                    const f32x4 a0 = acc[ai][0][m][0], a1 = acc[ai][0][m][1], b0 = acc[ai][1][m][0], b1 = acc[ai][1][m][1];
                    const f32x4 o10 = (a0 * c0 - b0 * s0) * sc, o11 = (a1 * c1 - b1 * s1) * sc, o20 = (b0 * c0 + a0 * s0) * sc, o21 = (b1 * c1 + a1 * s1) * sc;
                    bf16_t* rowp = base + (size_t)row * 2048 + head * 256 + cl;
                    *(u32x4*)rowp = pack8(o10, o11); *(u32x4*)(rowp + HALF) = pack8(o20, o21); }
        } else {
            const bool isg = u.pn >= 32; bf16_t* base = (isg ? G : V) + ((u.pn - (isg ? 32 : 16)) * 256 + cl);
#pragma unroll
            for (int ai = 0; ai < 2; ++ai)
#pragma unroll
                for (int m = 0; m < 4; ++m) { bf16_t* rowp = base + (size_t)(row0 + ai * HALF + m * 16) * 4096;
#pragma unroll
                    for (int bj = 0; bj < 2; ++bj) { f32x4 v0 = acc[ai][bj][m][0], v1 = acc[ai][bj][m][1];
                        if (isg) {
#pragma unroll
                            for (int e = 0; e < 4; ++e) { v0[e] = silu_f(v0[e]); v1[e] = silu_f(v1[e]); } }
                        *(u32x4*)(rowp + bj * HALF) = pack8(v0, v1); } }
        }
    }
};
struct EpiConvIn {
    static constexpr bool PERM = true, AFTER_DRAIN = false; static constexpr int NST = 8;
    bf16_t *Bg, *CU;
    __device__ __forceinline__ void operator()(const f32x4 (&acc)[2][2][4][2], const Unit& u, int wr, int wc, int fr, int fq) const {
        const int row0 = u.pm * BM + wr * 64 + fr, cl = wc * 32 + 8 * fq;
        if (u.pn < 8) {
#pragma unroll
            for (int ai = 0; ai < 2; ++ai)
#pragma unroll
                for (int m = 0; m < 4; ++m) { bf16_t* rowp = Bg + (size_t)(row0 + ai * HALF + m * 16) * 2048 + u.pn * 256 + cl;
#pragma unroll
                    for (int bj = 0; bj < 2; ++bj) *(u32x4*)(rowp + bj * HALF) = pack8(acc[ai][bj][m][0], acc[ai][bj][m][1]); }
        } else {
#pragma unroll
            for (int ai = 0; ai < 2; ++ai)
#pragma unroll
                for (int m = 0; m < 4; ++m) { bf16_t* rowp = CU + (size_t)(row0 + ai * HALF + m * 16) * 2048 + (u.pn - 8) * HALF + cl;
                    *(u32x4*)rowp = pack8(acc[ai][0][m][0] * acc[ai][1][m][0], acc[ai][0][m][1] * acc[ai][1][m][1]); }
        }
    }
};
struct EpiGlaIn {
    static constexpr bool PERM = true, AFTER_DRAIN = false; static constexpr int NST = 16;
    bf16_t *Q, *Kb, *V, *G;
    __device__ __forceinline__ void operator()(const f32x4 (&acc)[2][2][4][2], const Unit& u, int wr, int wc, int fr, int fq) const {
        const int row0 = u.pm * BM + wr * 64 + fr, cl = wc * 32 + 8 * fq;
        bf16_t* base; int ld; float sc = 1.f; const bool isg = u.pn >= 16;
        if (u.pn < 4) { base = Q + u.pn * 256; ld = 1024; sc = 0.0625f; } else if (u.pn < 8) { base = Kb + (u.pn - 4) * 256; ld = 1024; }
        else if (u.pn < 16) { base = V + (u.pn - 8) * 256; ld = 2048; } else { base = G + (u.pn - 16) * 256; ld = 2048; }
#pragma unroll
        for (int ai = 0; ai < 2; ++ai)
#pragma unroll
            for (int m = 0; m < 4; ++m) { bf16_t* rowp = base + (size_t)(row0 + ai * HALF + m * 16) * ld + cl;
#pragma unroll
                for (int bj = 0; bj < 2; ++bj) { f32x4 v0 = acc[ai][bj][m][0] * sc, v1 = acc[ai][bj][m][1] * sc;
                    if (isg) {
#pragma unroll
                        for (int e = 0; e < 4; ++e) { v0[e] = silu_f(v0[e]); v1[e] = silu_f(v1[e]); } }
                    *(u32x4*)(rowp + bj * HALF) = pack8(v0, v1); } }
    }
};
struct EpiNull {
    static constexpr bool PERM = true, AFTER_DRAIN = false; static constexpr int NST = 0;
    bf16_t* O;
    __device__ __forceinline__ void operator()(const f32x4 (&acc)[2][2][4][2], const Unit& u, int wr, int wc, int fr, int fq) const {
        float s = 0.f;
#pragma unroll
        for (int ai = 0; ai < 2; ++ai)
#pragma unroll
            for (int bj = 0; bj < 2; ++bj)
#pragma unroll
                for (int m = 0; m < 4; ++m)
#pragma unroll
                    for (int n = 0; n < 2; ++n) s += acc[ai][bj][m][n][0] + acc[ai][bj][m][n][1] + acc[ai][bj][m][n][2] + acc[ai][bj][m][n][3];
        if (s == 1.2345e30f) O[u.pm + fr] = 0;
    }
};
template <bool XIN_F32>
struct EpiRes {
    static constexpr bool PERM = true, AFTER_DRAIN = false; static constexpr int NST = 16;
    const void* xin; bf16_t* xout; const float* gate; const float* cscale;
    __device__ __forceinline__ void operator()(const f32x4 (&acc)[2][2][4][2], const Unit& u, int wr, int wc, int fr, int fq) const {
        const int row0 = u.pm * BM + wr * 64 + fr, col0 = u.pn * BM + wc * 32 + 8 * fq;
        const float* gp = gate + (size_t)(u.pm >> 3) * 12288 + col0;
        f32x4 gv[2][2];
#pragma unroll
        for (int bj = 0; bj < 2; ++bj)
#pragma unroll
            for (int n = 0; n < 2; ++n) { gv[bj][n] = *(const f32x4*)(gp + bj * HALF + n * 4); if (cscale) gv[bj][n] = gv[bj][n] * *(const f32x4*)(cscale + col0 + bj * HALF + n * 4); }
        if constexpr (XIN_F32) {
#pragma unroll
            for (int ai = 0; ai < 2; ++ai)
#pragma unroll
                for (int mh = 0; mh < 2; ++mh) { f32x4 xv[2][2][2];
#pragma unroll
                    for (int m2 = 0; m2 < 2; ++m2)
#pragma unroll
                        for (int bj = 0; bj < 2; ++bj) { const float* p = (const float*)xin + (size_t)(row0 + ai * HALF + (2 * mh + m2) * 16) * 2048 + col0 + bj * HALF; xv[m2][bj][0] = *(const f32x4*)p; xv[m2][bj][1] = *(const f32x4*)(p + 4); }
#pragma unroll
                    for (int m2 = 0; m2 < 2; ++m2)
#pragma unroll
                        for (int bj = 0; bj < 2; ++bj) { const int m = 2 * mh + m2;
                            *(u32x4*)(xout + (size_t)(row0 + ai * HALF + m * 16) * 2048 + col0 + bj * HALF) = pack8(xv[m2][bj][0] + gv[bj][0] * acc[ai][bj][m][0], xv[m2][bj][1] + gv[bj][1] * acc[ai][bj][m][1]); }
                    asm volatile("" ::: "memory"); }
        } else {
#pragma unroll
            for (int ai = 0; ai < 2; ++ai) { u32x4 xw[4][2];
#pragma unroll
                for (int m = 0; m < 4; ++m)
#pragma unroll
                    for (int bj = 0; bj < 2; ++bj) xw[m][bj] = *(const u32x4*)((const bf16_t*)xin + (size_t)(row0 + ai * HALF + m * 16) * 2048 + col0 + bj * HALF);
#pragma unroll
                for (int m = 0; m < 4; ++m)
#pragma unroll
                    for (int bj = 0; bj < 2; ++bj) { const u32x4 w = xw[m][bj];
                        const f32x4 x0 = (f32x4){__builtin_bit_cast(float, w.x << 16), __builtin_bit_cast(float, w.x & 0xffff0000u), __builtin_bit_cast(float, w.y << 16), __builtin_bit_cast(float, w.y & 0xffff0000u)};
                        const f32x4 x1 = (f32x4){__builtin_bit_cast(float, w.z << 16), __builtin_bit_cast(float, w.z & 0xffff0000u), __builtin_bit_cast(float, w.w << 16), __builtin_bit_cast(float, w.w & 0xffff0000u)};
                        *(u32x4*)(xout + (size_t)(row0 + ai * HALF + m * 16) * 2048 + col0 + bj * HALF) = pack8(x0 + gv[bj][0] * acc[ai][bj][m][0], x1 + gv[bj][1] * acc[ai][bj][m][1]); }
                asm volatile("" ::: "memory"); }
        }
    }
};

template <class Epi, class Sched, bool ALIGN_EPI = true, bool SP2 = true, bool FULLLINE = false, bool NOSTAGE = false, bool FP8 = false>
__device__ __forceinline__ void gemm_phase(PG8_LAS unsigned char* lds, const Gemm g, const Sched& S, const Epi& E) {
    const int tid = threadIdx.x, wid = __builtin_amdgcn_readfirstlane(tid >> 6), lane = tid & 63, wr = wid >> 2, wc = wid & 3, fr = lane & 15, fq = lane >> 4;
    const int K = g.K, nt = K / BK;
    unsigned voffA_, voffB_;
    { int R, C; stage_rc(tid * 16, R, C); const int Rb = Epi::PERM ? ((R & ~31) + perm32(R & 31)) : R;
      voffA_ = (unsigned)(R * g.lda + C) * 2u; voffB_ = (unsigned)(Rb * g.ldb + C) * 2u; }
    const unsigned voffA = voffA_, voffB = voffB_;
    const size_t pstepoffA = (size_t)64 * g.lda * 2, pstepoffB = (size_t)64 * g.ldb * 2;
    const size_t kstep = (size_t)(BK * 2);
    const size_t hstepA = (size_t)HALF * g.lda * 2, hstepB = (size_t)HALF * g.ldb * 2;
    const size_t tstepA = 2 * hstepA, tstepB = 2 * hstepB;
    const unsigned ldsw = (unsigned)wid * 1024u;
    const int aoff = lds_byte(wr * 64 + fr, fq * 8), boff = lds_byte(wc * 32 + fr, fq * 8);
#define PG8_SA(b, h) (((b) * 2 + (h)) * HTB)
#define PG8_SB(b, h) ((4 + (b) * 2 + (h)) * HTB)
#define PG8_STAGE(bufoff, gbase, voff) do { if constexpr (!NOSTAGE) _Pragma("unroll") for (int _i = 0; _i < 2; ++_i) \
        __builtin_amdgcn_global_load_lds((const unsigned*)((const char*)(gbase) + (size_t)_i * pstep##voff + v##voff), (PG8_LAS unsigned*)(lds + (bufoff) + ldsw + _i * 8192), 16, 0, 0); } while (0)
#define PG8_LDA(dst, b, h) do { _Pragma("unroll") for (int m = 0; m < 4; ++m) { const v4i_t l0_ = *(const PG8_LAS v4i_t*)(lds + PG8_SA(b, h) + aoff + m * 2048), l1_ = *(const PG8_LAS v4i_t*)(lds + PG8_SA(b, h) + aoff + m * 2048 + 1024); \
        dst[m] = __builtin_shufflevector(l0_, l1_, 0, 1, 2, 3, 4, 5, 6, 7); } } while (0)
#define PG8_LDB(dst, b, h) do { _Pragma("unroll") for (int n = 0; n < 2; ++n) { const v4i_t l0_ = *(const PG8_LAS v4i_t*)(lds + PG8_SB(b, h) + boff + n * 2048), l1_ = *(const PG8_LAS v4i_t*)(lds + PG8_SB(b, h) + boff + n * 2048 + 1024); \
        dst[n] = __builtin_shufflevector(l0_, l1_, 0, 1, 2, 3, 4, 5, 6, 7); } } while (0)
#define PG8_MMA(ai, bj, At, Bt) do { __builtin_amdgcn_sched_barrier(0); _Pragma("unroll") for (int m = 0; m < 4; ++m) _Pragma("unroll") for (int n = 0; n < 2; ++n) { \
        if constexpr (FP8) acc[ai][bj][m][n] = __builtin_amdgcn_mfma_scale_f32_16x16x128_f8f6f4(Bt[n], At[m], acc[ai][bj][m][n], 0, 0, 0, 0x7f7f7f7f, 0, 0x7f7f7f7f); \
        else { const v4i_t a0_ = __builtin_shufflevector(At[m], At[m], 0, 1, 2, 3), a1_ = __builtin_shufflevector(At[m], At[m], 4, 5, 6, 7), b0_ = __builtin_shufflevector(Bt[n], Bt[n], 0, 1, 2, 3), b1_ = __builtin_shufflevector(Bt[n], Bt[n], 4, 5, 6, 7); \
            acc[ai][bj][m][n] = __builtin_amdgcn_mfma_f32_16x16x32_bf16(__builtin_bit_cast(bf16x8, b0_), __builtin_bit_cast(bf16x8, a0_), acc[ai][bj][m][n], 0, 0, 0); \
            acc[ai][bj][m][n] = __builtin_amdgcn_mfma_f32_16x16x32_bf16(__builtin_bit_cast(bf16x8, b1_), __builtin_bit_cast(bf16x8, a1_), acc[ai][bj][m][n], 0, 0, 0); } } __builtin_amdgcn_sched_barrier(0); } while (0)
#define PG8_WAIT_V(n) asm volatile("s_waitcnt vmcnt(" #n ")" ::: "memory")
#define PG8_WAIT_L(n) asm volatile("s_waitcnt lgkmcnt(" #n ")" ::: "memory")
#define PG8_BAR __builtin_amdgcn_s_barrier()
#define PG8_SCHED __builtin_amdgcn_sched_barrier(0)
#define PG8_ABASE(u) ((const char*)g.A + (size_t)(u).pm * tstepA + (g.grp ? (size_t)(((u).pn * BM) / g.grp) * (size_t)g.grp * 2 : (size_t)0))
#define PG8_BBASE(u) ((const char*)g.Bt + (size_t)(u).pn * tstepB)
    Unit cur, nxt; int ui = 0;
    if (!S.next(0, cur)) return;
    f32x4 acc[2][2][4][2];
#pragma unroll
    for (int a = 0; a < 2; ++a)
#pragma unroll
        for (int b = 0; b < 2; ++b)
#pragma unroll
            for (int m = 0; m < 4; ++m)
#pragma unroll
                for (int n = 0; n < 2; ++n) acc[a][b][m][n] = (f32x4){0.f, 0.f, 0.f, 0.f};
    v8i_t At[4], B0[2], B1[2];
    const char* cA = PG8_ABASE(cur); const char* cB = PG8_BBASE(cur);
    S.a_ready(cur);
    if constexpr (SP2) {
    PG8_STAGE(PG8_SB(0, 0), cB, offB); PG8_STAGE(PG8_SB(0, 1), cB + hstepB, offB); PG8_STAGE(PG8_SA(0, 0), cA, offA); PG8_STAGE(PG8_SA(0, 1), cA + hstepA, offA);
    if (wr == 1) PG8_BAR;
    PG8_WAIT_V(2); PG8_BAR;
    PG8_STAGE(PG8_SB(1, 0), cB + kstep, offB); PG8_STAGE(PG8_SA(1, 0), cA + kstep, offA); PG8_STAGE(PG8_SB(1, 1), cB + hstepB + kstep, offB);
    PG8_WAIT_V(0); PG8_BAR;
    } else {
    PG8_STAGE(PG8_SB(0, 0), cB, offB); PG8_STAGE(PG8_SA(0, 0), cA, offA); PG8_STAGE(PG8_SB(0, 1), cB + hstepB, offB); PG8_STAGE(PG8_SA(0, 1), cA + hstepA, offA);
    if (wr == 1) PG8_BAR;
    PG8_WAIT_V(4); PG8_BAR;
    PG8_STAGE(PG8_SB(1, 0), cB + kstep, offB); PG8_STAGE(PG8_SA(1, 0), cA + kstep, offA); PG8_STAGE(PG8_SB(1, 1), cB + hstepB + kstep, offB);
    PG8_WAIT_V(6); PG8_BAR;
    }
    if (wr == 1) __builtin_amdgcn_s_setprio(1);
    for (;;) {
        const bool has_next = S.next(ui + 1, nxt);
        const char* nA = has_next ? PG8_ABASE(nxt) : cA; const char* nB = has_next ? PG8_BBASE(nxt) : cB;
#define PG8_ITER(WAITA) do { \
            const bool last = (t == nt - 2); \
            const char* a1 = cA + (size_t)(t + 1) * kstep; \
            const char* a2 = last ? nA : cA + (size_t)(t + 2) * kstep; const char* b2 = last ? nB : cB + (size_t)(t + 2) * kstep; \
            const char* a3 = a2 + kstep; const char* b3 = b2 + kstep; \
            if (last && has_next) S.a_ready(nxt); \
            PG8_LDB(B0, 0, 0); PG8_LDB(B1, 0, 1); PG8_SCHED; PG8_LDA(At, 0, 0); PG8_STAGE(PG8_SA(1, 1), a1 + hstepA, offA); \
            WAITA; PG8_WAIT_L(0); PG8_BAR; PG8_MMA(0, 0, At, B0); PG8_MMA(0, 1, At, B1); PG8_BAR; PG8_SCHED; \
            PG8_LDA(At, 0, 1); PG8_STAGE(PG8_SB(0, 0), b2, offB); PG8_STAGE(PG8_SB(0, 1), b2 + hstepB, offB); PG8_STAGE(PG8_SA(0, 0), a2, offA); \
            WAITA; PG8_WAIT_L(0); PG8_BAR; PG8_MMA(1, 0, At, B0); PG8_MMA(1, 1, At, B1); PG8_BAR; PG8_SCHED; \
            PG8_LDB(B0, 1, 0); PG8_LDB(B1, 1, 1); PG8_SCHED; PG8_LDA(At, 1, 0); PG8_STAGE(PG8_SA(0, 1), a2 + hstepA, offA); \
            PG8_WAIT_V(8); PG8_WAIT_L(0); PG8_BAR; PG8_MMA(0, 0, At, B0); PG8_MMA(0, 1, At, B1); PG8_BAR; PG8_SCHED; \
            PG8_LDA(At, 1, 1); PG8_STAGE(PG8_SB(1, 0), b3, offB); PG8_STAGE(PG8_SB(1, 1), b3 + hstepB, offB); PG8_STAGE(PG8_SA(1, 0), a3, offA); \
            PG8_WAIT_V(8); PG8_WAIT_L(0); PG8_BAR; PG8_MMA(1, 0, At, B0); PG8_MMA(1, 1, At, B1); PG8_BAR; PG8_SCHED; } while (0)
        static_assert(SP2, "only the SP2 loop is kept");
        { const int t = 0; if constexpr (Epi::NST == 16) PG8_ITER(PG8_WAIT_V(24)); else if constexpr (Epi::NST == 8) PG8_ITER(PG8_WAIT_V(16)); else PG8_ITER(PG8_WAIT_V(8)); }
        for (int t = 2; t < nt; t += 2) PG8_ITER(PG8_WAIT_V(8));
#undef PG8_ITER
        if constexpr (ALIGN_EPI) { if (wr == 0) PG8_BAR; }
        { int ln_ = lane; asm volatile("" : "+v"(ln_));
          E(acc, cur, wr, wc, ln_ & 15, ln_ >> 4); } S.done(cur);
        if (!has_next) break;
#pragma unroll
        for (int a = 0; a < 2; ++a)
#pragma unroll
            for (int b = 0; b < 2; ++b)
#pragma unroll
                for (int m = 0; m < 4; ++m)
#pragma unroll
                    for (int n = 0; n < 2; ++n) acc[a][b][m][n] = (f32x4){0.f, 0.f, 0.f, 0.f};
        cur = nxt; cA = nA; cB = nB; ++ui;
        if constexpr (ALIGN_EPI) { if (wr == 1) PG8_BAR; }
    }
    __builtin_amdgcn_s_setprio(0);
    PG8_WAIT_V(0);
    if constexpr (!ALIGN_EPI) { if (wr == 0) PG8_BAR; }
    PG8_BAR;
#undef PG8_SA
#undef PG8_SB
#undef PG8_STAGE
#undef PG8_LDA
#undef PG8_LDB
#undef PG8_MMA
#undef PG8_WAIT_V
#undef PG8_WAIT_L
#undef PG8_BAR
#undef PG8_SCHED
#undef PG8_ABASE
#undef PG8_BBASE
}
}

constexpr int NWAVES = 8;
constexpr int BATCH = 8, SEQ = 2048, D = 2048, M = BATCH * SEQ, DEPTH = 4;
constexpr int FF = 5632, FF2 = 2 * FF;
constexpr int RET_H = 8, RET_IN = 12288, RET_VW = 4096;
constexpr int GLA_H = 4, GLA_QK = 1024, GLA_VW = 2048, GLA_INW = 6160, GLA_MAIN = 6144;
constexpr int CONV_INW = 6144;
constexpr float EPS = 1e-6f;
constexpr int MODW = 6 * D;

constexpr size_t MiB = 1u << 20;
constexpr size_t WS_CTL = 0, CTL_ZERO_BYTES = 1 * MiB;
constexpr size_t WS_MOD = 1 * MiB;
constexpr size_t WS_Z = 3 * MiB;
constexpr size_t WS_WZT = 4 * MiB;
constexpr size_t WS_COS = 5 * MiB, WS_SIN = 13 * MiB;
constexpr size_t WS_W_RET_IN = 21 * MiB;
constexpr size_t WS_W_RET_OUT = 69 * MiB;
constexpr size_t WS_W_CONV_IN = 85 * MiB;
constexpr size_t WS_W_CONV_OUT = 109 * MiB;
constexpr size_t WS_W_GLA_IN = 117 * MiB;
constexpr size_t WS_W_GLA_OUT = 141 * MiB;
constexpr size_t WS_W_POOL = 149 * MiB;
constexpr size_t WS_W_FFN_IN = 151 * MiB;
constexpr size_t WS_W_FFN_OUT = 327 * MiB;
constexpr size_t WS_X = 415 * MiB;
constexpr size_t WS_H = 479 * MiB;
constexpr size_t WS_ACT = 543 * MiB;
constexpr size_t WS_FH = WS_ACT + 512 * MiB;
constexpr size_t WS_END = WS_FH + 176 * MiB;
constexpr size_t A_RQ = WS_ACT, A_RK = WS_ACT + 64 * MiB, A_RV = WS_ACT + 128 * MiB, A_RG = WS_ACT + 256 * MiB, A_RO = WS_ACT + 384 * MiB;
constexpr size_t A_CB = WS_ACT, A_CCU = WS_ACT + 64 * MiB, A_CY = WS_ACT + 128 * MiB;
constexpr size_t A_GE = WS_ACT + 448 * MiB;
constexpr size_t A_GQ = WS_ACT, A_GK = WS_ACT + 32 * MiB, A_GV = WS_ACT + 64 * MiB, A_GG = WS_ACT + 128 * MiB, A_GO = WS_ACT + 192 * MiB;
constexpr size_t A_PM = WS_ACT;
constexpr size_t A_FH = WS_FH;
constexpr int CW_TMO = 0, CW_BAR = 4096;

constexpr int RING_BYTES = 131072;
constexpr int LDSCTL_OFF = RING_BYTES, MISC_OFF = LDSCTL_OFF + 320;
constexpr int LDS_BYTES = 147456;

#define GAS __attribute__((address_space(1)))
#define LAS __attribute__((address_space(3)))
typedef unsigned short bf16;
typedef unsigned v4u __attribute__((ext_vector_type(4)));
typedef unsigned v2u __attribute__((ext_vector_type(2)));
typedef float f32x4 __attribute__((ext_vector_type(4)));
typedef GAS unsigned gu32;
#define RLX_AGENT __ATOMIC_RELAXED, __HIP_MEMORY_SCOPE_AGENT
#define LDS_WAIT() asm volatile("s_waitcnt lgkmcnt(0)" ::: "memory")
__device__ __forceinline__ unsigned f2bf(float f) { unsigned u = __builtin_bit_cast(unsigned, f); return (u + 0x7fffu + ((u >> 16) & 1u)) >> 16; }
__device__ __forceinline__ unsigned pk2(float lo, float hi) { return f2bf(lo) | (f2bf(hi) << 16); }
__device__ __forceinline__ v2u pack8_fp8(float a0, float a1, float a2, float a3, float a4, float a5, float a6, float a7, float sc) {
    int lo = __builtin_amdgcn_cvt_pk_fp8_f32(a0 * sc, a1 * sc, 0, false); lo = __builtin_amdgcn_cvt_pk_fp8_f32(a2 * sc, a3 * sc, lo, true);
    int hi = __builtin_amdgcn_cvt_pk_fp8_f32(a4 * sc, a5 * sc, 0, false); hi = __builtin_amdgcn_cvt_pk_fp8_f32(a6 * sc, a7 * sc, hi, true);
    v2u r; r.x = (unsigned)lo; r.y = (unsigned)hi; return r;
}
constexpr float FP8_ASCALE = 4.0f, FP8_WSCALE = 64.0f;
__device__ __forceinline__ float bflo(unsigned w) { return __builtin_bit_cast(float, w << 16); }
__device__ __forceinline__ float bfhi(unsigned w) { return __builtin_bit_cast(float, w & 0xffff0000u); }

__device__ __forceinline__ void unpack8(const v4u& w, float (&f)[8]) { f[0] = bflo(w.x); f[1] = bfhi(w.x); f[2] = bflo(w.y); f[3] = bfhi(w.y); f[4] = bflo(w.z); f[5] = bfhi(w.z); f[6] = bflo(w.w); f[7] = bfhi(w.w); }
#define XB_TMO      128
#define XB_XCNT(j)  (256  + 64 * (j))
#define XB_XSUB(j)  (1280 + 64 * (j))
#define XB_XGEN(j)  (2304 + 64 * (j))
#define XB_TOP      3328
#define XB_TOPGEN   3392
#define XCD_BAR_WORDS 3456
#define XB_GCNT(j)  (3456 + 64 * (j))
#define XB_LATE     4700
#define XB_XTAB     4096
#define XB_SPIN_CAP (1u << 18)
__device__ __forceinline__ unsigned xb_ld(unsigned* p)              { return __hip_atomic_load(p, __ATOMIC_RELAXED, __HIP_MEMORY_SCOPE_AGENT); }
__device__ __forceinline__ unsigned xb_add(unsigned* p, unsigned v) { return __hip_atomic_fetch_add(p, v, __ATOMIC_RELAXED, __HIP_MEMORY_SCOPE_AGENT); }
__device__ __forceinline__ unsigned xb_xcc_id() { return (unsigned)__builtin_amdgcn_s_getreg((3 << 11) | 20) & 0xFu; }
#define XB_SPIN(cond, bar) do { unsigned _sp = 0; while (cond) { __builtin_amdgcn_s_sleep(1); \
    if ((++_sp & 255u) == 0u) { if (xb_ld(&(bar)[XB_TMO])) break; if (_sp > XB_SPIN_CAP) { atomicAdd(&(bar)[XB_TMO], 1u); break; } } } } while (0)
struct XcdBarrier { unsigned* bar; unsigned x; volatile LAS unsigned* st; };
__device__ __forceinline__ XcdBarrier xcd_barrier_post(unsigned* bar, volatile LAS unsigned* st) {
    XcdBarrier b; b.bar = bar; b.x = xb_xcc_id(); b.st = st;
    if (threadIdx.x == 0) { (void)xb_add(&bar[XB_XCNT(b.x)], 1u); __hip_atomic_store(&bar[XB_XTAB + blockIdx.x], b.x + 1u, RLX_AGENT); }
    return b;
}
__device__ __forceinline__ void xcd_barrier_complete(unsigned* bar, unsigned x, unsigned& nloc, unsigned& nx) {
    const unsigned G = gridDim.x * gridDim.y * gridDim.z;
    unsigned sum, cnt, mine, sp = 0u;
    for (;;) {
        sum = 0u; cnt = 0u; mine = 0u;
#pragma unroll
        for (unsigned j = 0; j < 16; ++j) { const unsigned c = xb_ld(&bar[XB_XCNT(j)]); sum += c; cnt += (c > 0u) ? 1u : 0u; mine = (j == x) ? c : mine; }
        if (sum == G) break;
        __builtin_amdgcn_s_sleep(1);
        if ((++sp & 255u) == 0u) { if (xb_ld(&bar[XB_TMO])) break; if (sp > XB_SPIN_CAP) { atomicAdd(&bar[XB_TMO], 1u); break; } }
    }
    nloc = mine > 0u ? mine : 1u; nx = cnt > 0u ? cnt : 1u;
}
__device__ __forceinline__ void xcd_barrier(const XcdBarrier& b, bool global = false) {
    asm volatile("s_waitcnt vmcnt(0)" ::: "memory");
    __syncthreads();
    if (threadIdx.x == 0) {
        unsigned* bar = b.bar;
        __builtin_amdgcn_s_waitcnt(0);
        if (!global && b.st[2] != 0u) {
            const unsigned gen = b.st[3]; b.st[3] = gen + 1u;
            unsigned* gc = &bar[XB_GCNT(blockIdx.x & 7u)];
            (void)xb_add(gc, 1u);
            asm volatile("buffer_inv sc1" ::: "memory");
            XB_SPIN(xb_ld(gc) < 32u * (gen + 1u), bar);
            asm volatile("s_waitcnt vmcnt(0)" ::: "memory");
        } else {
        unsigned nloc = b.st[0], nx = b.st[1];
        if (nloc == 0u) { xcd_barrier_complete(bar, b.x, nloc, nx); b.st[0] = nloc; b.st[1] = nx; }
        const unsigned old = xb_add(&bar[XB_XSUB(b.x)], 1u);
        const unsigned gen = old / nloc;
        if (old + 1u == (gen + 1u) * nloc) {
            __builtin_amdgcn_fence(__ATOMIC_RELEASE, "agent");
            asm volatile("s_waitcnt vmcnt(0)" ::: "memory");
            const unsigned og = xb_add(&bar[XB_TOP], 1u);
            const unsigned tg = og / nx;
            if (og + 1u == (tg + 1u) * nx) xb_add(&bar[XB_TOPGEN], 1u);
            else XB_SPIN(xb_ld(&bar[XB_TOPGEN]) == tg, bar);
            __builtin_amdgcn_fence(__ATOMIC_ACQUIRE, "agent");
            xb_add(&bar[XB_XGEN(b.x)], 1u);
            asm volatile("s_waitcnt vmcnt(0)" ::: "memory");
        } else {
            XB_SPIN(xb_ld(&bar[XB_XGEN(b.x)]) == gen, bar);
            __builtin_amdgcn_fence(__ATOMIC_ACQUIRE, "agent");
            asm volatile("s_waitcnt vmcnt(0)" ::: "memory");
        }
        }
    }
    __syncthreads();
}

__device__ __forceinline__ float wave_sum(float v) {
#pragma unroll
    for (int o = 1; o < 64; o <<= 1) v += __shfl_xor(v, o);
    return v;
}
__device__ __forceinline__ void sincos_acc(float a, float& s, float& c) {
    const double x = (double)a;
    const double n = rint(x * 0.63661977236758134308);
    double r = fma(-n, 1.5707963267948966192, x); r = fma(-n, 6.123233995736766036e-17, r);
    const double r2 = r * r;
    double sp = -2.5052108385441718775e-8; sp = fma(sp, r2, 2.7557319223985890653e-6); sp = fma(sp, r2, -1.9841269841269841270e-4); sp = fma(sp, r2, 8.3333333333333333333e-3); sp = fma(sp, r2, -1.6666666666666666667e-1);
    const double sr = fma(sp * r2, r, r);
    double cp = 2.0876756987868098979e-9; cp = fma(cp, r2, -2.7557319223985890653e-7); cp = fma(cp, r2, 2.4801587301587301587e-5); cp = fma(cp, r2, -1.3888888888888888889e-3); cp = fma(cp, r2, 4.1666666666666666667e-2); cp = fma(cp, r2, -0.5);
    const double cr = fma(cp, r2, 1.0);
    const int q = ((int)n) & 3;
    const double ss = (q & 1) ? cr : sr, cc = (q & 1) ? sr : cr;
    s = (float)((q & 2) ? -ss : ss); c = (float)(((q + 1) & 2) ? -cc : cc);
}

template <bool F8>
__device__ __forceinline__ void transpose_item(const float* W, int ldw, int k0, int srccol0, bf16* WT, int ldt, int dstrow0, LAS float* scr, int lane) {
    float wv[32];
#pragma unroll
    for (int i = 0; i < 32; ++i) wv[i] = W[(size_t)(k0 + 2 * i + (lane >> 5)) * ldw + srccol0 + (lane & 31)];
#pragma unroll
    for (int i = 0; i < 32; ++i) scr[(2 * i + (lane >> 5)) * 33 + (lane & 31)] = wv[i];
    LDS_WAIT(); asm volatile("" ::: "memory");
    const int c = lane & 7;
#pragma unroll
    for (int j = 0; j < 4; ++j) { const int n = (lane >> 3) + 8 * j; const LAS float* s = scr + (8 * c) * 33 + n;
        if constexpr (F8) { *(v2u*)((unsigned char*)WT + (size_t)(dstrow0 + n) * ldt + k0 + 8 * c) = pack8_fp8(s[0 * 33], s[1 * 33], s[2 * 33], s[3 * 33], s[4 * 33], s[5 * 33], s[6 * 33], s[7 * 33], FP8_WSCALE); }
        else { v4u o; o.x = pk2(s[0 * 33], s[1 * 33]); o.y = pk2(s[2 * 33], s[3 * 33]); o.z = pk2(s[4 * 33], s[5 * 33]); o.w = pk2(s[6 * 33], s[7 * 33]);
            *(v4u*)(WT + (size_t)(dstrow0 + n) * ldt + k0 + 8 * c) = o; } }
    LDS_WAIT(); asm volatile("" ::: "memory");
}
struct TJob { const float* src; bf16* dst; int ldw, K, Nd, mode; };
struct Args { const void* in[21]; float* out; unsigned char* ws; int ph_lo, ph_hi; };

__device__ __forceinline__ TJob get_job(const Args& a, int j) {
    unsigned char* ws = a.ws; TJob t;
    if (j == 0)      { t.src = (const float*)a.in[7];  t.dst = (bf16*)(ws + WS_W_RET_IN);  t.ldw = RET_IN;   t.K = D;        t.Nd = RET_IN;   t.mode = 0; }
    else if (j == 1) { t.src = (const float*)a.in[8];  t.dst = (bf16*)(ws + WS_W_RET_OUT); t.ldw = D;        t.K = RET_VW;   t.Nd = D;        t.mode = 0; }
    else if (j == 2) { t.src = (const float*)a.in[9];  t.dst = (bf16*)(ws + WS_W_CONV_IN); t.ldw = CONV_INW; t.K = D;        t.Nd = CONV_INW; t.mode = 2; }
    else if (j == 3) { t.src = (const float*)a.in[11]; t.dst = (bf16*)(ws + WS_W_CONV_OUT); t.ldw = D;       t.K = D;        t.Nd = D;        t.mode = 0; }
    else if (j == 4) { t.src = (const float*)a.in[12]; t.dst = (bf16*)(ws + WS_W_GLA_IN);  t.ldw = GLA_INW;  t.K = D;        t.Nd = GLA_MAIN; t.mode = 0; }
    else if (j == 5) { t.src = (const float*)a.in[15]; t.dst = (bf16*)(ws + WS_W_GLA_OUT); t.ldw = D;        t.K = D;        t.Nd = D;        t.mode = 0; }
    else if (j < 10) { const int g = j - 6;  t.src = (const float*)a.in[16] + (size_t)g * 512 * 512; t.dst = (bf16*)(ws + WS_W_POOL) + (size_t)g * 512 * 512; t.ldw = 512; t.K = 512; t.Nd = 512; t.mode = 0; }
    else if (j < 14) { const int l = j - 10; t.src = (const float*)a.in[18] + (size_t)l * D * FF2;   t.dst = (bf16*)(ws + WS_W_FFN_IN) + (size_t)l * FF2 * D;  t.ldw = FF2; t.K = D;   t.Nd = FF2; t.mode = 1; }
    else             { const int l = j - 14; t.src = (const float*)a.in[19] + (size_t)l * FF * D;    t.dst = (bf16*)(ws + WS_W_FFN_OUT) + (size_t)l * D * FF;  t.ldw = D;   t.K = FF;  t.Nd = D;   t.mode = 0; }
    return t;
}
constexpr int NJOBS = 18;
__device__ __forceinline__ int job_src_col(int mode, int n) {
    if (mode == 1) { const int tile = n >> 8, r = n & 255; return r < 128 ? tile * 128 + r : FF + tile * 128 + (r - 128); }
    if (mode == 2) { if (n < 2048) return n; const int nn = n - 2048, tile = nn >> 8, r = nn & 255; return r < 128 ? 2048 + tile * 128 + r : 4096 + tile * 128 + (r - 128); }
    return n;
}

__device__ __forceinline__ void transposes_masked(const Args& a, LAS unsigned char* lds, int lane, int wave, unsigned mask, int wid, int nw) {
    LAS float* scr = (LAS float*)(lds + wave * 16384);
    int base = 0;
    for (int j = 0; j < NJOBS; ++j) {
        if (!((mask >> j) & 1u)) continue;
        const TJob t = get_job(a, j);
        const int nblk = t.Nd / 32, nitems = (t.K / 64) * nblk;
        int it = base + ((wid - base % nw) + nw) % nw;
        const bool f8 = (j >= 10 && j < 14) && ((FP8_FFN_MASK >> (j - 10)) & 1);
        for (; it < base + nitems; it += nw) { const int r = it - base, kb = r / nblk, nb = r % nblk;
            if (f8) transpose_item<true>(t.src, t.ldw, kb * 64, job_src_col(t.mode, nb * 32), t.dst, t.K, nb * 32, scr, lane);
            else transpose_item<false>(t.src, t.ldw, kb * 64, job_src_col(t.mode, nb * 32), t.dst, t.K, nb * 32, scr, lane); }
        base += nitems;
    }
}
constexpr unsigned ALL_JOBS = (1u << NJOBS) - 1u;
constexpr unsigned LATE_JOBS = (0xFu << 6) | (1u << 13) | (1u << 17) | (1u << 16) | (1u << 12);

__device__ __forceinline__ void prologue_phase(const Args& a, LAS unsigned char* lds, int tid, int lane, int wave, int vcu, int G, bool late_w) {
    unsigned char* ws = a.ws;
    {
        LAS float* cact = (LAS float*)lds;
        LAS float* red = (LAS float*)(lds + 65536);
        const float* c = (const float*)a.in[1];
        for (int i = tid; i < 8 * 2048; i += 512) { const int b = i >> 11, k = i & 2047; const float v = c[i]; cact[k * 8 + b] = v / (1.0f + __expf(-v)); }
        __syncthreads();
        const float* wmod = (const float*)a.in[3]; const float* bmod = (const float*)a.in[4]; float* mod = (float*)(ws + WS_MOD);
        for (int item = vcu; item < 4 * 48; item += G) {
            const int l = item / 48, n0 = (item % 48) * 256;
            const float* W = wmod + (size_t)l * D * MODW + n0 + 4 * lane;
            f32x4 acc[8];
#pragma unroll
            for (int b = 0; b < 8; ++b) acc[b] = (f32x4){0.f, 0.f, 0.f, 0.f};
            for (int kk = 0; kk < 256; kk += 8) {
                f32x4 w[8];
#pragma unroll
                for (int u = 0; u < 8; ++u) w[u] = *(const f32x4*)(W + (size_t)(wave * 256 + kk + u) * MODW);
#pragma unroll
                for (int u = 0; u < 8; ++u) { const int k = wave * 256 + kk + u; const f32x4 c0 = *(const LAS f32x4*)(cact + k * 8), c1 = *(const LAS f32x4*)(cact + k * 8 + 4);
                    acc[0] += w[u] * c0[0]; acc[1] += w[u] * c0[1]; acc[2] += w[u] * c0[2]; acc[3] += w[u] * c0[3];
                    acc[4] += w[u] * c1[0]; acc[5] += w[u] * c1[1]; acc[6] += w[u] * c1[2]; acc[7] += w[u] * c1[3]; }
            }
#pragma unroll
            for (int b = 0; b < 8; ++b) *(LAS f32x4*)(red + (wave * 8 + b) * 256 + 4 * lane) = acc[b];
            __syncthreads();
            { const int b = tid >> 6; f32x4 s = *(const f32x4*)(bmod + (size_t)l * MODW + n0 + 4 * lane);
#pragma unroll
              for (int w = 0; w < 8; ++w) s += *(const LAS f32x4*)(red + (w * 8 + b) * 256 + 4 * lane);
              *(f32x4*)(mod + (size_t)(l * 8 + b) * MODW + n0 + 4 * lane) = s; }
            __syncthreads();
        }
        __syncthreads();
    }
    const int gw = vcu * NWAVES + wave, NGW = G * NWAVES;
    transposes_masked(a, lds, lane, wave, late_w ? (ALL_JOBS & ~LATE_JOBS) : ALL_JOBS, gw, NGW);
    const int gtid = vcu * 512 + tid, NT = G * 512;
    { const float* w = (const float*)a.in[12]; float* wzt = (float*)(ws + WS_WZT);
      for (int i = gtid; i < 16 * 2048; i += NT) { const int r = i >> 11, k = i & 2047; wzt[i] = w[(size_t)k * GLA_INW + GLA_MAIN + r]; } }
    { const int* pos = (const int*)a.in[2]; float* ct = (float*)(ws + WS_COS); float* st = (float*)(ws + WS_SIN);
      for (int i = gtid; i < M * 128; i += NT) { const int m = i >> 7, j = i & 127;
          const float lin = (float)j * (1.0f / 127.0f); const float inv = exp2f(-lin * 13.287712379549449f);
          const float ang = (float)pos[m] * inv; float s, c; sincos_acc(ang, s, c); ct[i] = c; st[i] = s; } }
}

__device__ __forceinline__ float reduce16(const float (&p)[16], int lane) {
    float a[8], b[4], c[2];
    { const bool hi = (lane & 32) != 0;
#pragma unroll
      for (int k = 0; k < 8; ++k) { const float send = hi ? p[k] : p[k + 8], keep = hi ? p[k + 8] : p[k]; a[k] = keep + __shfl_xor(send, 32); } }
    { const bool hi = (lane & 16) != 0;
#pragma unroll
      for (int k = 0; k < 4; ++k) { const float send = hi ? a[k] : a[k + 4], keep = hi ? a[k + 4] : a[k]; b[k] = keep + __shfl_xor(send, 16); } }
    { const bool hi = (lane & 8) != 0;
#pragma unroll
      for (int k = 0; k < 2; ++k) { const float send = hi ? b[k] : b[k + 2], keep = hi ? b[k + 2] : b[k]; c[k] = keep + __shfl_xor(send, 8); } }
    const bool hi4 = (lane & 4) != 0; const float send = hi4 ? c[0] : c[1], keep = hi4 ? c[1] : c[0];
    float d = keep + __shfl_xor(send, 4);
    d += __shfl_xor(d, 2); d += __shfl_xor(d, 1);
    return d;
}
template <bool ZP, bool XF32, bool OUT8 = false>
__device__ __forceinline__ void norm_phase(LAS unsigned char* lds, const void* xin, const float* gain, const float* sh, const float* sc, bf16* hout, const float* wzt, float* zout, int lane, int wave, int vcu, int G) {
    const int gw = vcu * NWAVES + wave, NGW = G * NWAVES;
    LAS float* wl = (LAS float*)lds;
    if constexpr (ZP) {
        for (int i = threadIdx.x; i < 8192; i += NWAVES * 64) { const int ln = i & 63, half = (i >> 6) & 1, j = (i >> 7) & 3, rr = i >> 9;
            *(LAS f32x4*)(wl + i * 4) = *(const f32x4*)(wzt + (size_t)rr * D + 512 * j + 8 * ln + 4 * half); }
        __syncthreads();
    }
    const bool xdeal = (G == 256);
    const int nit = xdeal ? 4 : (M + 2 * NGW - 1) / (2 * NGW);
    for (int it_ = 0; it_ < nit; ++it_) {
        const int m0 = xdeal ? 2048 * (gw >> 8) + 2 * (gw & 255) + 512 * it_ : 2 * gw + it_ * 2 * NGW;
        if (m0 >= M) break;
        f32x4 v[2][4][2]; float ss[2] = {0.f, 0.f};
#pragma unroll
        for (int r = 0; r < 2; ++r)
#pragma unroll
            for (int j = 0; j < 4; ++j) {
                if constexpr (XF32) { const float* xr = (const float*)xin + (size_t)(m0 + r) * D + 8 * lane; v[r][j][0] = *(const f32x4*)(xr + 512 * j); v[r][j][1] = *(const f32x4*)(xr + 512 * j + 4); }
                else { float f[8]; unpack8(*(const v4u*)((const bf16*)xin + (size_t)(m0 + r) * D + 8 * lane + 512 * j), f); v[r][j][0] = (f32x4){f[0], f[1], f[2], f[3]}; v[r][j][1] = (f32x4){f[4], f[5], f[6], f[7]}; } }
#pragma unroll
        for (int r = 0; r < 2; ++r)
#pragma unroll
            for (int j = 0; j < 4; ++j)
#pragma unroll
                for (int e = 0; e < 4; ++e) ss[r] += v[r][j][0][e] * v[r][j][0][e] + v[r][j][1][e] * v[r][j][1][e];
#pragma unroll
        for (int r = 0; r < 2; ++r) { const int m = m0 + r, b = m >> 11;
            const float rstd = rsqrtf(wave_sum(ss[r]) * (1.0f / D) + EPS);
#pragma unroll
            for (int j = 0; j < 4; ++j) { const int col = 512 * j + 8 * lane;
#pragma unroll
                for (int q = 0; q < 2; ++q) { const f32x4 gg = *(const f32x4*)(gain + col + 4 * q), s1 = *(const f32x4*)(sc + (size_t)b * MODW + col + 4 * q), s0 = *(const f32x4*)(sh + (size_t)b * MODW + col + 4 * q);
                    v[r][j][q] = (v[r][j][q] * rstd * gg) * (s1 + 1.0f) + s0; }
                if constexpr (OUT8) { *(v2u*)((unsigned char*)hout + (size_t)m * D + col) = pack8_fp8(v[r][j][0][0], v[r][j][0][1], v[r][j][0][2], v[r][j][0][3], v[r][j][1][0], v[r][j][1][1], v[r][j][1][2], v[r][j][1][3], FP8_ASCALE); }
                else { v4u o; o.x = pk2(v[r][j][0][0], v[r][j][0][1]); o.y = pk2(v[r][j][0][2], v[r][j][0][3]); o.z = pk2(v[r][j][1][0], v[r][j][1][1]); o.w = pk2(v[r][j][1][2], v[r][j][1][3]);
                    *(v4u*)(hout + (size_t)m * D + col) = o; } }
        }
        if constexpr (ZP) {
            float p0[16], p1[16];
#pragma unroll
            for (int rr = 0; rr < 16; ++rr) { p0[rr] = 0.f; p1[rr] = 0.f;
#pragma unroll
                for (int j = 0; j < 4; ++j) { const f32x4 w0 = *(const LAS f32x4*)(wl + (((rr * 4 + j) * 2 + 0) * 64 + lane) * 4), w1 = *(const LAS f32x4*)(wl + (((rr * 4 + j) * 2 + 1) * 64 + lane) * 4);
#pragma unroll
                    for (int e = 0; e < 4; ++e) { p0[rr] += v[0][j][0][e] * w0[e] + v[0][j][1][e] * w1[e]; p1[rr] += v[1][j][0][e] * w0[e] + v[1][j][1][e] * w1[e]; } } }
            const float z0 = reduce16(p0, lane), z1 = reduce16(p1, lane);
            if ((lane & 3) == 0) { const int rr = ((lane >> 5) & 1) * 8 + ((lane >> 4) & 1) * 4 + ((lane >> 3) & 1) * 2 + ((lane >> 2) & 1);
                zout[(size_t)m0 * 16 + rr] = z0; zout[(size_t)(m0 + 1) * 16 + rr] = z1; }
        }
    }
}
__device__ __forceinline__ void final_norm_phase(const bf16* xin, const float* gain, float* out, int lane, int wave, int vcu, int G) {
    const int gw = vcu * NWAVES + wave, NGW = G * NWAVES;
    const bool xdeal = (G == 256);
    const int nit = xdeal ? 4 : (M + 2 * NGW - 1) / (2 * NGW);
    for (int it_ = 0; it_ < nit; ++it_) {
        const int m0 = xdeal ? 2048 * (gw >> 8) + 2 * (gw & 255) + 512 * it_ : 2 * gw + it_ * 2 * NGW;
        if (m0 >= M) break;
        float v[2][4][8]; float ss[2] = {0.f, 0.f};
#pragma unroll
        for (int r = 0; r < 2; ++r)
#pragma unroll
            for (int j = 0; j < 4; ++j) unpack8(*(const v4u*)(xin + (size_t)(m0 + r) * D + 8 * lane + 512 * j), v[r][j]);
#pragma unroll
        for (int r = 0; r < 2; ++r)
#pragma unroll
            for (int j = 0; j < 4; ++j)
#pragma unroll
                for (int e = 0; e < 8; ++e) ss[r] += v[r][j][e] * v[r][j][e];
#pragma unroll
        for (int r = 0; r < 2; ++r) { const int m = m0 + r;
            const float rstd = rsqrtf(wave_sum(ss[r]) * (1.0f / D) + EPS);
#pragma unroll
            for (int j = 0; j < 4; ++j) { const int col = 512 * j + 8 * lane; const f32x4 g0 = *(const f32x4*)(gain + col), g1 = *(const f32x4*)(gain + col + 4);
                *(f32x4*)(out + (size_t)m * D + col) = (f32x4){v[r][j][0], v[r][j][1], v[r][j][2], v[r][j][3]} * rstd * g0;
                *(f32x4*)(out + (size_t)m * D + col + 4) = (f32x4){v[r][j][4], v[r][j][5], v[r][j][6], v[r][j][7]} * rstd * g1; } }
    }
}
__device__ __forceinline__ void post_phase(bf16* O, const bf16* Gt, int nheads, int lane, int wave, int vcu, int G) {
    const int gw = vcu * NWAVES + wave, NGW = G * NWAVES, nitems = M * nheads;
    const bool xdeal = (G == 256);
    const int nit = xdeal ? 2 * nheads : (nitems + 4 * NGW - 1) / (4 * NGW);
    for (int it_ = 0; it_ < nit; ++it_) {
        const int it0 = xdeal ? (gw >> 8) * SEQ * nheads + 4 * (gw & 255) + 1024 * it_ : 4 * gw + it_ * 4 * NGW;
        if (it0 >= nitems) break;
        v4u ov[4], gv[4];
#pragma unroll
        for (int u = 0; u < 4; ++u) { const size_t off = (size_t)(it0 + u) * 512 + 8 * lane; ov[u] = *(const v4u*)(O + off); gv[u] = *(const v4u*)(Gt + off); }
#pragma unroll
        for (int u = 0; u < 4; ++u) { const size_t off = (size_t)(it0 + u) * 512 + 8 * lane;
            float o[8], g[8]; unpack8(ov[u], o); unpack8(gv[u], g);
            float ss = 0.f;
#pragma unroll
            for (int e = 0; e < 8; ++e) ss += o[e] * o[e];
            const float rstd = rsqrtf(wave_sum(ss) * (1.0f / 512.0f) + EPS);
            v4u w; w.x = pk2(g[0] * o[0] * rstd, g[1] * o[1] * rstd); w.y = pk2(g[2] * o[2] * rstd, g[3] * o[3] * rstd); w.z = pk2(g[4] * o[4] * rstd, g[5] * o[5] * rstd); w.w = pk2(g[6] * o[6] * rstd, g[7] * o[7] * rstd);
            *(v4u*)(O + off) = w; }
    }
}
__device__ __forceinline__ void conv_phase(const bf16* Bg, const bf16* CU, bf16* Y, const float* cw, int tid, int vcu, int G) {
    const int gtid = vcu * 512 + tid, NT = G * 512;
    for (int task = gtid; task < 256 * 512; task += NT) {
        const int cg = task & 255, run = task >> 8, m0 = run * 32, col = cg * 8;
        float w0[8], w1[8], w2[8], p2[8], p1[8];
#pragma unroll
        for (int e = 0; e < 8; ++e) { w0[e] = cw[col + e]; w1[e] = cw[D + col + e]; w2[e] = cw[2 * D + col + e]; p2[e] = 0.f; p1[e] = 0.f; }
        if ((m0 & (SEQ - 1)) != 0) { unpack8(*(const v4u*)(CU + (size_t)(m0 - 2) * D + col), p2); unpack8(*(const v4u*)(CU + (size_t)(m0 - 1) * D + col), p1); }
        for (int r0 = 0; r0 < 32; r0 += 8) { v4u cw[8], bw[8];
#pragma unroll
            for (int u = 0; u < 8; ++u) { const size_t off = (size_t)(m0 + r0 + u) * D + col; cw[u] = *(const v4u*)(CU + off); bw[u] = *(const v4u*)(Bg + off); }
#pragma unroll
            for (int u = 0; u < 8; ++u) { const size_t off = (size_t)(m0 + r0 + u) * D + col;
                float cu[8], bg[8], y[8]; unpack8(cw[u], cu); unpack8(bw[u], bg);
#pragma unroll
                for (int e = 0; e < 8; ++e) { y[e] = bg[e] * (w0[e] * p2[e] + w1[e] * p1[e] + w2[e] * cu[e]); p2[e] = p1[e]; p1[e] = cu[e]; }
                v4u w; w.x = pk2(y[0], y[1]); w.y = pk2(y[2], y[3]); w.z = pk2(y[4], y[5]); w.w = pk2(y[6], y[7]);
                *(v4u*)(Y + off) = w; } }
    }
}
__device__ __forceinline__ void pool_phase(const bf16* H, bf16* MX, int tid, int vcu, int G) {
    const int gtid = vcu * 512 + tid, NT = G * 512;
    for (int task = gtid; task < 256 * 512; task += NT) {
        const int cg = task & 255, run = task >> 8, m0 = run * 32, col = cg * 8, win = 2 << (cg >> 6), t0 = m0 & (SEQ - 1);
        const bf16* hp = H + (size_t)m0 * D + col;
        float sum[8];
#pragma unroll
        for (int e = 0; e < 8; ++e) sum[e] = 0.f;
        if (t0 != 0) {
            v4u pw[16];
#pragma unroll
            for (int j = 0; j < 16; ++j) pw[j] = (j < win) ? *(const v4u*)(hp - (ptrdiff_t)(j + 1) * D) : (v4u){0u, 0u, 0u, 0u};
#pragma unroll
            for (int j = 0; j < 16; ++j) { float f[8]; unpack8(pw[j], f);
#pragma unroll
                for (int e = 0; e < 8; ++e) sum[e] += f[e]; }
        }
        for (int r0 = 0; r0 < 32; r0 += 8) {
            v4u cw[8], ow[8];
#pragma unroll
            for (int u = 0; u < 8; ++u) { const int r = r0 + u; cw[u] = *(const v4u*)(hp + (size_t)r * D);
                ow[u] = (t0 + r - win >= 0) ? *(const v4u*)(hp + (ptrdiff_t)(r - win) * D) : (v4u){0u, 0u, 0u, 0u}; }
#pragma unroll
            for (int u = 0; u < 8; ++u) { const int r = r0 + u, t = t0 + r; const int cnt = (t + 1 < win) ? t + 1 : win;
                float cur[8], old[8], y[8]; unpack8(cw[u], cur); unpack8(ow[u], old);
                const float inv = 1.0f / (float)cnt;
#pragma unroll
                for (int e = 0; e < 8; ++e) { sum[e] += cur[e] - old[e]; y[e] = sum[e] * inv - cur[e]; }
                v4u w; w.x = pk2(y[0], y[1]); w.y = pk2(y[2], y[3]); w.z = pk2(y[4], y[5]); w.w = pk2(y[6], y[7]);
                *(v4u*)(MX + (size_t)(m0 + r) * D + col) = w; }
        }
    }
}

typedef short s16x4 __attribute__((ext_vector_type(4)));
typedef short bf16x8s __attribute__((ext_vector_type(8)));
typedef float f32x2s __attribute__((ext_vector_type(2)));
typedef __bf16 bf16x2_t __attribute__((ext_vector_type(2)));
__device__ __forceinline__ unsigned cvt2(float a, float b) { f32x2s v = {a, b}; bf16x2_t r = __builtin_convertvector(v, bf16x2_t); return __builtin_bit_cast(unsigned, r); }
__device__ __forceinline__ s16x4 ldtr(LAS const unsigned char* p) { return __builtin_bit_cast(s16x4, __builtin_amdgcn_ds_read_tr16_b64_v4i16((LAS s16x4*)p)); }
constexpr int SC_QS = 528, SC_KS = 544, SC_VS = 288, SC_PS = 160, SC_OS = 272;
constexpr int SC_QI = 0, SC_KI = SC_QI + 64 * SC_QS, SC_VI = SC_KI + 64 * SC_KS, SC_PI = SC_VI + 64 * SC_VS, SC_OI = SC_PI + 64 * SC_PS, SC_EI = SC_OI + 64 * SC_OS, SC_END = SC_EI + 1024;
static_assert(SC_END <= RING_BYTES, "scan LDS map");
#define SC_BAR() do { asm volatile("s_waitcnt lgkmcnt(0)" ::: "memory"); __builtin_amdgcn_s_barrier(); asm volatile("" ::: "memory"); } while (0)
template <bool GLA>
__device__ __forceinline__ void scan_item2(LAS unsigned char* lds, const bf16* Qd, const bf16* Kd, const bf16* V, bf16* O, const float* EG, int ldqk, int ldv, int b, int h, int dvs, float e_const, int tid) {
    const int lane = tid & 63, w = __builtin_amdgcn_readfirstlane(tid >> 6), fr = lane & 15, fq = lane >> 4, q4 = fr >> 2, p4 = fr & 3;
    if (w >= 4) {
        const int t2 = tid - 256, cw = w - 4;
        const bf16* qg = Qd + (size_t)(b * SEQ + (t2 >> 5)) * ldqk + h * 256 + (t2 & 31) * 8;
        const bf16* kg = Kd + (size_t)(b * SEQ + (t2 >> 5)) * ldqk + h * 256 + (t2 & 31) * 8;
        const bf16* vg = V + (size_t)(b * SEQ + (t2 >> 4)) * ldv + h * 512 + dvs * 128 + (t2 & 15) * 8;
        const float* eg = GLA ? EG + (size_t)(b * 32) * 1024 + h * 256 + (t2 & 63) * 4 : nullptr;
        LAS unsigned char* qw = lds + SC_QI + (t2 >> 5) * SC_QS + (t2 & 31) * 16;
        LAS unsigned char* kw = lds + SC_KI + (t2 >> 5) * SC_KS + (t2 & 31) * 16;
        LAS unsigned char* vw = lds + SC_VI + (t2 >> 4) * SC_VS + (t2 & 15) * 16;
        v4u qr[8], kr[8], vr[4]; f32x4 er = (f32x4){0.f, 0.f, 0.f, 0.f};
#pragma unroll
        for (int k = 0; k < 8; ++k) { qr[k] = *(const v4u*)(qg + (size_t)(8 * k) * ldqk); kr[k] = *(const v4u*)(kg + (size_t)(8 * k) * ldqk); }
#pragma unroll
        for (int k = 0; k < 4; ++k) vr[k] = *(const v4u*)(vg + (size_t)(16 * k) * ldv);
        if (GLA && t2 < 64) er = *(const f32x4*)eg;
        for (int c = 0; c < SEQ / 64; ++c) {
#pragma unroll
            for (int k = 0; k < 8; ++k) { *(LAS v4u*)(qw + 8 * k * SC_QS) = qr[k]; *(LAS v4u*)(kw + 8 * k * SC_KS) = kr[k]; }
#pragma unroll
            for (int k = 0; k < 4; ++k) *(LAS v4u*)(vw + 16 * k * SC_VS) = vr[k];
            if (GLA && t2 < 64) *(LAS f32x4*)(lds + SC_EI + t2 * 16) = er;
            SC_BAR();
            if (c + 1 < SEQ / 64) { const size_t adv = (size_t)(c + 1) * 64;
#pragma unroll
                for (int k = 0; k < 8; ++k) { qr[k] = *(const v4u*)(qg + (adv + 8 * k) * ldqk); kr[k] = *(const v4u*)(kg + (adv + 8 * k) * ldqk); }
#pragma unroll
                for (int k = 0; k < 4; ++k) vr[k] = *(const v4u*)(vg + (adv + 16 * k) * ldv);
                if (GLA && t2 < 64) er = *(const f32x4*)(eg + (size_t)(c + 1) * 1024); }
            f32x4 sa[4];
#pragma unroll
            for (int tj = 0; tj < 4; ++tj) sa[tj] = (f32x4){0.f, 0.f, 0.f, 0.f};
            bf16x8s fbq[3], fak[3][4];
#define LD_S(buf, ks) do { fbq[buf] = *(const LAS bf16x8s*)(lds + SC_QI + (16 * cw + fr) * SC_QS + (32 * (ks) + 8 * fq) * 2); \
                _Pragma("unroll") for (int tj = 0; tj < 4; ++tj) fak[buf][tj] = *(const LAS bf16x8s*)(lds + SC_KI + (16 * tj + fr) * SC_KS + (32 * (ks) + 8 * fq) * 2); } while (0)
            LD_S(0, 0); LD_S(1, 1); LD_S(2, 2);
#pragma unroll
            for (int ks = 0; ks < 8; ++ks) {
                __builtin_amdgcn_sched_barrier(0);
#pragma unroll
                for (int tj = 0; tj < 4; ++tj) sa[tj] = __builtin_amdgcn_mfma_f32_16x16x32_bf16(fak[ks % 3][tj], fbq[ks % 3], sa[tj], 0, 0, 0);
                __builtin_amdgcn_sched_barrier(0);
                if (ks + 3 < 8) LD_S(ks % 3, ks + 3);
            }
#undef LD_S
            { const int i = 16 * cw + fr;
#pragma unroll
              for (int tj = 0; tj < 4; ++tj) { const int j0 = 16 * tj + 4 * fq;
                  const float p0 = (j0 + 0 <= i) ? sa[tj][0] : 0.f, p1 = (j0 + 1 <= i) ? sa[tj][1] : 0.f, p2 = (j0 + 2 <= i) ? sa[tj][2] : 0.f, p3 = (j0 + 3 <= i) ? sa[tj][3] : 0.f;
                  v2u pw; pw.x = cvt2(p0, p1); pw.y = cvt2(p2, p3);
                  *(LAS v2u*)(lds + SC_PI + i * SC_PS + j0 * 2) = pw; } }
            SC_BAR();
        }
        SC_BAR();
    } else {
        f32x4 st[16][2];
#pragma unroll
        for (int t = 0; t < 16; ++t) { st[t][0] = (f32x4){0.f, 0.f, 0.f, 0.f}; st[t][1] = (f32x4){0.f, 0.f, 0.f, 0.f}; }
        bf16* const obase = O + (size_t)(b * SEQ) * ldv + h * 512 + dvs * 128 + 32 * w;
        const unsigned ooff = (unsigned)(fr * ldv + 4 * fq) * 2u;
        for (int c = 0; c < SEQ / 64; ++c) {
            SC_BAR();
            f32x4 oa[4][2];
#pragma unroll
            for (int ti = 0; ti < 4; ++ti) { oa[ti][0] = (f32x4){0.f, 0.f, 0.f, 0.f}; oa[ti][1] = (f32x4){0.f, 0.f, 0.f, 0.f}; }
            v2u faq[2][4][2];
#define LD_C1(buf, s_) do { _Pragma("unroll") for (int ti = 0; ti < 4; ++ti) { LAS const unsigned char* ap_ = lds + SC_QI + (16 * ti + fr) * SC_QS + (32 * (s_) + 4 * fq) * 2; \
                faq[buf][ti][0] = *(const LAS v2u*)ap_; faq[buf][ti][1] = *(const LAS v2u*)(ap_ + 32); } } while (0)
            s16x4 fkt[3][2][2]; bf16x8s bv[2][2];
#define LD_C2(buf, g) do { const int ks_ = (g) >> 3, t0_ = 2 * ((g) & 7); _Pragma("unroll") for (int t = 0; t < 2; ++t) { \
                fkt[buf][t][0] = ldtr(lds + SC_KI + (32 * ks_ + 8 * fq + q4) * SC_KS + (16 * (t0_ + t) + 4 * p4) * 2); \
                fkt[buf][t][1] = ldtr(lds + SC_KI + (32 * ks_ + 8 * fq + 4 + q4) * SC_KS + (16 * (t0_ + t) + 4 * p4) * 2); } } while (0)
            LD_C1(0, 0);
#pragma unroll
            for (int s_ = 0; s_ < 8; ++s_) {
                if (s_ + 1 < 8) LD_C1((s_ + 1) & 1, s_ + 1); else { LD_C2(0, 0); LD_C2(1, 1); }
                __builtin_amdgcn_sched_barrier(0);
#pragma unroll
                for (int ct = 0; ct < 2; ++ct) {
                    v4u sbw; sbw.x = cvt2(st[2 * s_][ct][0], st[2 * s_][ct][1]); sbw.y = cvt2(st[2 * s_][ct][2], st[2 * s_][ct][3]); sbw.z = cvt2(st[2 * s_ + 1][ct][0], st[2 * s_ + 1][ct][1]); sbw.w = cvt2(st[2 * s_ + 1][ct][2], st[2 * s_ + 1][ct][3]);
                    const bf16x8s sb = __builtin_bit_cast(bf16x8s, sbw);
#pragma unroll
                    for (int ti = 0; ti < 4; ++ti) { v4u aw; aw.x = faq[s_ & 1][ti][0].x; aw.y = faq[s_ & 1][ti][0].y; aw.z = faq[s_ & 1][ti][1].x; aw.w = faq[s_ & 1][ti][1].y;
                        oa[ti][ct] = __builtin_amdgcn_mfma_f32_16x16x32_bf16(sb, __builtin_bit_cast(bf16x8s, aw), oa[ti][ct], 0, 0, 0); } }
                __builtin_amdgcn_sched_barrier(0);
            }
#pragma unroll
            for (int ks = 0; ks < 2; ++ks)
#pragma unroll
                for (int ct = 0; ct < 2; ++ct) { const s16x4 lo = ldtr(lds + SC_VI + (32 * ks + 8 * fq + q4) * SC_VS + (32 * w + 16 * ct + 4 * p4) * 2), hi = ldtr(lds + SC_VI + (32 * ks + 8 * fq + 4 + q4) * SC_VS + (32 * w + 16 * ct + 4 * p4) * 2);
                    bv[ks][ct] = __builtin_shufflevector(lo, hi, 0, 1, 2, 3, 4, 5, 6, 7); }
#pragma unroll
            for (int g = 0; g < 16; ++g) {
                if (g + 2 < 16) LD_C2((g + 2) % 3, g + 2);
                __builtin_amdgcn_sched_barrier(0);
#pragma unroll
                for (int t = 0; t < 2; ++t) { const bf16x8s ak = __builtin_shufflevector(fkt[g % 3][t][0], fkt[g % 3][t][1], 0, 1, 2, 3, 4, 5, 6, 7);
#pragma unroll
                    for (int ct = 0; ct < 2; ++ct) st[2 * (g & 7) + t][ct] = __builtin_amdgcn_mfma_f32_16x16x32_bf16(ak, bv[g >> 3][ct], st[2 * (g & 7) + t][ct], 0, 0, 0); }
                __builtin_amdgcn_sched_barrier(0);
            }
#undef LD_C1
#undef LD_C2
#pragma unroll
            for (int t = 0; t < 16; ++t) { if (GLA) { const f32x4 e4 = *(const LAS f32x4*)(lds + SC_EI + (16 * t + 4 * fq) * 4); st[t][0] = st[t][0] * e4; st[t][1] = st[t][1] * e4; } else { st[t][0] = st[t][0] * e_const; st[t][1] = st[t][1] * e_const; } }
            SC_BAR();
#pragma unroll
            for (int ks = 0; ks < 2; ++ks) { bf16x8s ap[4];
#pragma unroll
                for (int ti = 0; ti < 4; ++ti) ap[ti] = *(const LAS bf16x8s*)(lds + SC_PI + (16 * ti + fr) * SC_PS + (32 * ks + 8 * fq) * 2);
#pragma unroll
                for (int ti = 0; ti < 4; ++ti)
#pragma unroll
                    for (int ct = 0; ct < 2; ++ct) oa[ti][ct] = __builtin_amdgcn_mfma_f32_16x16x32_bf16(bv[ks][ct], ap[ti], oa[ti][ct], 0, 0, 0); }
#pragma unroll
            for (int ti = 0; ti < 4; ++ti)
#pragma unroll
                for (int ct = 0; ct < 2; ++ct) { v2u ow; ow.x = cvt2(oa[ti][ct][0], oa[ti][ct][1]); ow.y = cvt2(oa[ti][ct][2], oa[ti][ct][3]);
                    *(v2u*)((char*)(obase + ((size_t)c * 64 + 16 * ti) * ldv + 16 * ct) + ooff) = ow; }
        }
        SC_BAR();
    }
}
__device__ __forceinline__ void gla_prep_item(LAS unsigned char* lds, bf16* Q, bf16* Kb, const float* Z, const float* Wg, const float* bgate, float* EG, int item, int tid) {
    const int m0 = item * 64;
    LAS float* zs = (LAS float*)lds;
    zs[tid] = Z[(size_t)m0 * 16 + tid]; zs[tid + 512] = Z[(size_t)m0 * 16 + tid + 512];
    __syncthreads();
    const int n = 2 * tid;
    float wg0[16], wg1[16];
#pragma unroll
    for (int r = 0; r < 16; ++r) { const f32x2s wv = *(const f32x2s*)(Wg + r * GLA_QK + n); wg0[r] = wv[0]; wg1[r] = wv[1]; }
    const float bg0 = bgate[n], bg1 = bgate[n + 1];
    float b0 = 0.f, b1 = 0.f;
    unsigned* qp = (unsigned*)(Q + (size_t)m0 * GLA_QK + n); unsigned* kp = (unsigned*)(Kb + (size_t)m0 * GLA_QK + n);
    for (int t0 = 0; t0 < 64; t0 += 8) {
        unsigned qv[8], kv[8];
#pragma unroll
        for (int u = 0; u < 8; ++u) { qv[u] = qp[(size_t)(t0 + u) * (GLA_QK / 2)]; kv[u] = kp[(size_t)(t0 + u) * (GLA_QK / 2)]; }
#pragma unroll
        for (int u = 0; u < 8; ++u) { const int t = t0 + u; float x0 = bg0, x1 = bg1;
#pragma unroll
            for (int r4 = 0; r4 < 4; ++r4) { const f32x4 z4 = *(const LAS f32x4*)(zs + t * 16 + r4 * 4);
#pragma unroll
                for (int e = 0; e < 4; ++e) { x0 = fmaf(z4[e], wg0[4 * r4 + e], x0); x1 = fmaf(z4[e], wg1[4 * r4 + e], x1); } }
            b0 += (fminf(x0, 0.f) - __logf(1.0f + __expf(-fabsf(x0)))) * 0.0625f;
            b1 += (fminf(x1, 0.f) - __logf(1.0f + __expf(-fabsf(x1)))) * 0.0625f;
            const float e0 = __expf(b0), e1 = __expf(b1), i0 = __expf(-b0), i1 = __expf(-b1);
            qp[(size_t)t * (GLA_QK / 2)] = cvt2(bflo(qv[u]) * e0, bfhi(qv[u]) * e1);
            kp[(size_t)t * (GLA_QK / 2)] = cvt2(bflo(kv[u]) * i0, bfhi(kv[u]) * i1); }
    }
    *(f32x2s*)(EG + (size_t)item * GLA_QK + n) = (f32x2s){__expf(b0), __expf(b1)};
    __syncthreads();
}

constexpr int N_PHASES = 32;
__global__ void __launch_bounds__(NWAVES * 64, 2) fwd_kernel(Args args_byval) {
    (void)args_byval; const Args& args = *(const Args*)__builtin_amdgcn_kernarg_segment_ptr();
    extern __shared__ __attribute__((aligned(16))) unsigned char lds_raw[];
    LAS unsigned char* lds = (LAS unsigned char*)lds_raw;
    volatile LAS unsigned* MISC = (volatile LAS unsigned*)(lds + MISC_OFF);
    const int tid = threadIdx.x, lane = tid & 63, wave = __builtin_amdgcn_readfirstlane(tid >> 6);
    const int G = gridDim.x; const int bx = blockIdx.x; const int vcu = (G % 8 == 0) ? (bx % 8) * (G / 8) + bx / 8 : bx;
    unsigned char* ws = args.ws;
    gu32* ctl = (gu32*)(ws + WS_CTL);
    for (int u = tid; u < (LDS_BYTES - LDSCTL_OFF) / 4; u += NWAVES * 64) ((LAS unsigned*)(lds + LDSCTL_OFF))[u] = 0u;
    __syncthreads();
    XcdBarrier bar; bar.bar = (unsigned*)(ctl + CW_BAR); bar.x = 0; bar.st = nullptr;
    if (MK_ONE_LAUNCH) bar = xcd_barrier_post((unsigned*)(ctl + CW_BAR), MISC + 8);
    const int lo = args.ph_lo, hi = args.ph_hi;
    const bool late_w = MK_ONE_LAUNCH && G == 256 && lo == 0 && hi == N_PHASES;
    int ph = 0;
#define PHASE_BEGIN if (lo <= ph && ph < hi) { int tl_ = threadIdx.x; asm volatile("" : "+v"(tl_)); const int tid = tl_, lane = tl_ & 63; (void)tid; (void)lane;
#define PHASE_END   if (MK_ONE_LAUNCH && ph + 1 < hi) xcd_barrier(bar); } ++ph;
#define LATE_CONVERT() if (late_w && bx >= 128) { \
        transposes_masked(args, lds, lane, wave, LATE_JOBS, (bx - 128) * NWAVES + wave, 128 * NWAVES); \
        asm volatile("s_waitcnt vmcnt(0)" ::: "memory"); __syncthreads(); \
        if (tid == 0) { __builtin_amdgcn_fence(__ATOMIC_RELEASE, "agent"); asm volatile("s_waitcnt vmcnt(0)" ::: "memory"); (void)xb_add((unsigned*)(ctl + CW_BAR) + XB_LATE, 1u); } }
#define LATE_WAIT() if (late_w) { if (tid == 0) { unsigned* lb_ = (unsigned*)(ctl + CW_BAR); XB_SPIN(xb_ld(lb_ + XB_LATE) < 128u, lb_); \
        __builtin_amdgcn_fence(__ATOMIC_ACQUIRE, "agent"); asm volatile("s_waitcnt vmcnt(0)" ::: "memory"); } __syncthreads(); }
#define PHASE_END_GRID(glob) if (MK_ONE_LAUNCH && ph + 1 < hi) xcd_barrier(bar, glob); } ++ph;

    const float* x_in = (const float*)args.in[0];
    bf16* X = (bf16*)(ws + WS_X);
    bf16* Hb = (bf16*)(ws + WS_H);
    const float* mod = (const float*)(ws + WS_MOD);
    const float* n1g = (const float*)args.in[5]; const float* n2g = (const float*)args.in[6];
    bf16* FH = (bf16*)(ws + A_FH);

    PHASE_BEGIN prologue_phase(args, lds, tid, lane, wave, vcu, G, late_w); PHASE_END
    if (MK_ONE_LAUNCH && lo == 0 && hi > 1 && wave == 0) {
        unsigned* xt = (unsigned*)(ctl + CW_BAR) + XB_XTAB;
        bool ok = (G == 256);
#pragma unroll
        for (int k = 0; k < 4; ++k) { const int e = lane + 64 * k; if (e < G) ok = ok && (xb_ld(xt + e) == xb_ld(xt + (e & 7))); }
        const bool all = __builtin_amdgcn_ballot_w64(ok) == ~0ull;
        if (tid == 0) MISC[8 + 2] = all ? 1u : 0u;
    }

#define MODP(l, idx) (mod + (size_t)(l) * 8 * MODW + (size_t)(idx) * D)
#define NORM1(l, xsrc, ZP, XF) PHASE_BEGIN norm_phase<ZP, XF>(lds, xsrc, n1g + (l) * D, MODP(l, 0), MODP(l, 1), Hb, (const float*)(ws + WS_WZT), (float*)(ws + WS_Z), lane, wave, vcu, G); PHASE_END
#define FFN(l) \
    PHASE_BEGIN if constexpr ((FP8_FFN_MASK >> (l)) & 1) norm_phase<false, false, true>(lds, X, n2g + (l) * D, MODP(l, 3), MODP(l, 4), Hb, nullptr, nullptr, lane, wave, vcu, G); \
                else norm_phase<false, false, false>(lds, X, n2g + (l) * D, MODP(l, 3), MODP(l, 4), Hb, nullptr, nullptr, lane, wave, vcu, G); PHASE_END \
    PHASE_BEGIN { if ((l) == 2) { LATE_WAIT() } } if constexpr ((FP8_FFN_MASK >> (l)) & 1) { pg8::Gemm g{Hb, (const bf16*)(ws + WS_W_FFN_IN) + (size_t)(l) * FF2 * D, M, FF2, D / 2, D / 2, D / 2, 0}; pg8::StaticOrder S; S.init(M, FF2, G, bx); \
            pg8::EpiSwigluS E{FH, FF, 1.0f / (FP8_ASCALE * FP8_WSCALE)}; pg8::gemm_phase<pg8::EpiSwigluS, pg8::StaticOrder, true, true, false, false, true>(lds, g, S, E); } \
        else { pg8::Gemm g{Hb, (const bf16*)(ws + WS_W_FFN_IN) + (size_t)(l) * FF2 * D, M, FF2, D, D, D, 0}; pg8::StaticOrder S; S.init(M, FF2, G, bx); \
            pg8::EpiSwiglu E{FH, FF, 1.0f}; pg8::gemm_phase<pg8::EpiSwiglu, pg8::StaticOrder>(lds, g, S, E); } PHASE_END \
    PHASE_BEGIN { pg8::Gemm g{FH, (const bf16*)(ws + WS_W_FFN_OUT) + (size_t)(l) * D * FF, M, D, FF, FF, FF, 0}; pg8::StaticOrder S; S.init(M, D, G, bx); \
        pg8::EpiRes<false> E{X, X, MODP(l, 5), nullptr}; pg8::gemm_phase<pg8::EpiRes<false>, pg8::StaticOrder>(lds, g, S, E); } PHASE_END_GRID((l) < DEPTH - 1)

    NORM1(0, x_in, false, true)
    PHASE_BEGIN { pg8::Gemm g{Hb, (const bf16*)(ws + WS_W_RET_IN), M, RET_IN, D, D, D, 0}; pg8::StaticOrder S; S.init(M, RET_IN, G, bx);
        pg8::EpiRetIn E{(bf16*)(ws + A_RQ), (bf16*)(ws + A_RK), (bf16*)(ws + A_RV), (bf16*)(ws + A_RG), (const float*)(ws + WS_COS), (const float*)(ws + WS_SIN)};
        pg8::gemm_phase<pg8::EpiRetIn, pg8::StaticOrder>(lds, g, S, E); } PHASE_END
#define RET_SCAN PHASE_BEGIN for (int item = bx; item < 256; item += G) { const int pr = 8 * (item & 7) + (item >> 5), dvs_ = (item >> 3) & 3, hh = pr & 7;     \
        const float l2g = log1pf(-exp2f(-5.0f - (float)hh)) * 1.4426950408889634f; \
        scan_item2<false>(lds, (const bf16*)(ws + A_RQ), (const bf16*)(ws + A_RK), (const bf16*)(ws + A_RV), (bf16*)(ws + A_RO), nullptr, 2048, 4096, pr >> 3, hh, dvs_, exp2f(64.0f * l2g), tid); } PHASE_END
    RET_SCAN
    PHASE_BEGIN post_phase((bf16*)(ws + A_RO), (const bf16*)(ws + A_RG), RET_H, lane, wave, vcu, G); PHASE_END
    PHASE_BEGIN { pg8::Gemm g{(const bf16*)(ws + A_RO), (const bf16*)(ws + WS_W_RET_OUT), M, D, RET_VW, RET_VW, RET_VW, 0}; pg8::StaticOrder S; S.init(M, D, G, bx);
        pg8::EpiRes<true> E{x_in, X, MODP(0, 2), nullptr}; pg8::gemm_phase<pg8::EpiRes<true>, pg8::StaticOrder>(lds, g, S, E); } PHASE_END
    FFN(0)
    NORM1(1, X, false, false)
    PHASE_BEGIN { pg8::Gemm g{Hb, (const bf16*)(ws + WS_W_CONV_IN), M, CONV_INW, D, D, D, 0}; pg8::StaticOrder S; S.init(M, CONV_INW, G, bx);
        pg8::EpiConvIn E{(bf16*)(ws + A_CB), (bf16*)(ws + A_CCU)}; pg8::gemm_phase<pg8::EpiConvIn, pg8::StaticOrder>(lds, g, S, E); } PHASE_END
    PHASE_BEGIN conv_phase((const bf16*)(ws + A_CB), (const bf16*)(ws + A_CCU), (bf16*)(ws + A_CY), (const float*)args.in[10], tid, vcu, G); PHASE_END
    PHASE_BEGIN { pg8::Gemm g{(const bf16*)(ws + A_CY), (const bf16*)(ws + WS_W_CONV_OUT), M, D, D, D, D, 0}; pg8::StaticOrder S; S.init(M, D, G, bx);
        pg8::EpiRes<false> E{X, X, MODP(1, 2), nullptr}; pg8::gemm_phase<pg8::EpiRes<false>, pg8::StaticOrder>(lds, g, S, E); } PHASE_END
    FFN(1)
    NORM1(2, X, true, false)
    PHASE_BEGIN { pg8::Gemm g{Hb, (const bf16*)(ws + WS_W_GLA_IN), M, GLA_MAIN, D, D, D, 0}; pg8::StaticOrder S; S.init(M, GLA_MAIN, G, bx);
        pg8::EpiGlaIn E{(bf16*)(ws + A_GQ), (bf16*)(ws + A_GK), (bf16*)(ws + A_GV), (bf16*)(ws + A_GG)}; pg8::gemm_phase<pg8::EpiGlaIn, pg8::StaticOrder>(lds, g, S, E); } PHASE_END
    PHASE_BEGIN for (int item = bx; item < 256; item += G) gla_prep_item(lds, (bf16*)(ws + A_GQ), (bf16*)(ws + A_GK), (const float*)(ws + WS_Z), (const float*)args.in[13], (const float*)args.in[14], (float*)(ws + A_GE), 32 * (item & 7) + (item >> 3), tid); PHASE_END
#define GLA_SCAN PHASE_BEGIN LATE_CONVERT() for (int item = bx; item < 128; item += G) { const int pr = 4 * (item & 7) + (item >> 5), dvs_ = (item >> 3) & 3;     \
        scan_item2<true>(lds, (const bf16*)(ws + A_GQ), (const bf16*)(ws + A_GK), (const bf16*)(ws + A_GV), (bf16*)(ws + A_GO), (const float*)(ws + A_GE), \
        1024, 2048, pr >> 2, pr & 3, dvs_, 1.0f, tid); } PHASE_END
    GLA_SCAN
    PHASE_BEGIN post_phase((bf16*)(ws + A_GO), (const bf16*)(ws + A_GG), GLA_H, lane, wave, vcu, G); PHASE_END
    PHASE_BEGIN { pg8::Gemm g{(const bf16*)(ws + A_GO), (const bf16*)(ws + WS_W_GLA_OUT), M, D, D, D, D, 0}; pg8::StaticOrder S; S.init(M, D, G, bx);
        pg8::EpiRes<false> E{X, X, MODP(2, 2), nullptr}; pg8::gemm_phase<pg8::EpiRes<false>, pg8::StaticOrder>(lds, g, S, E); } PHASE_END
    FFN(2)
    NORM1(3, X, false, false)
    PHASE_BEGIN pool_phase(Hb, (bf16*)(ws + A_PM), tid, vcu, G); PHASE_END
    PHASE_BEGIN { pg8::Gemm g{(const bf16*)(ws + A_PM), (const bf16*)(ws + WS_W_POOL), M, D, 512, D, 512, 512}; pg8::StaticOrder S; S.init(M, D, G, bx);
        pg8::EpiRes<false> E{X, X, MODP(3, 2), (const float*)args.in[17]}; pg8::gemm_phase<pg8::EpiRes<false>, pg8::StaticOrder>(lds, g, S, E); } PHASE_END
    FFN(3)
    PHASE_BEGIN final_norm_phase(X, (const float*)args.in[20], args.out, lane, wave, vcu, G); PHASE_END
#undef PHASE_BEGIN
#undef PHASE_END
#undef PHASE_END_GRID
#undef LATE_CONVERT
#undef LATE_WAIT
}

extern "C" void kernel_launch(void* const* d_in, const int* in_sizes, int n_in, void* d_out, int out_size, void* d_ws, size_t ws_size, hipStream_t stream) {
    static int grid = 0;
    if (grid == 0) {
        if (n_in != 21 || in_sizes[0] != M * D || out_size != M * D || ws_size < WS_END) { fprintf(stderr, "kernel_launch: unexpected shapes (n_in %d, in0 %d, out %d, ws %zu, need %zu); nothing launched\n", n_in, n_in > 0 ? in_sizes[0] : -1, out_size, ws_size, (size_t)WS_END); grid = -1; return; }
        int dev = 0, cus = 0, per_cu = 0;
        if (hipGetDevice(&dev) != hipSuccess || hipDeviceGetAttribute(&cus, hipDeviceAttributeMultiprocessorCount, dev) != hipSuccess) { grid = -1; return; }
        if (hipFuncSetAttribute((const void*)fwd_kernel, hipFuncAttributeMaxDynamicSharedMemorySize, LDS_BYTES) != hipSuccess) { fprintf(stderr, "kernel_launch: hipFuncSetAttribute failed\n"); grid = -1; return; }
        if (hipOccupancyMaxActiveBlocksPerMultiprocessor(&per_cu, (const void*)fwd_kernel, NWAVES * 64, LDS_BYTES) != hipSuccess || per_cu < 1)
            fprintf(stderr, "kernel_launch: note: occupancy query reports %d workgroups per CU\n", per_cu);
        (void)hipGetLastError();
        grid = cus;
    }
    if (grid < 0) return;
    if (hipMemsetAsync((char*)d_ws + WS_CTL, 0, CTL_ZERO_BYTES, stream) != hipSuccess) { fprintf(stderr, "kernel_launch: memset failed\n"); return; }
    Args a{};
    for (int i = 0; i < 21; ++i) a.in[i] = d_in[i];
    a.out = (float*)d_out; a.ws = (unsigned char*)d_ws;
#if MK_ONE_LAUNCH
    a.ph_lo = 0; a.ph_hi = N_PHASES;
    hipLaunchKernelGGL(fwd_kernel, dim3(grid), dim3(NWAVES * 64), LDS_BYTES, stream, a);
#else
    for (int p = 0; p < N_PHASES; ++p) { a.ph_lo = p; a.ph_hi = p + 1; hipLaunchKernelGGL(fwd_kernel, dim3(grid), dim3(NWAVES * 64), LDS_BYTES, stream, a); }
#endif
    const hipError_t le = hipPeekAtLastError();
    if (le != hipSuccess) fprintf(stderr, "kernel_launch: launch failed: %s\n", hipGetErrorName(le));
}
```
